# Optimizing an MI355X kernel written in HIP

```python
import math
import jax, jax.numpy as jnp
from jax import lax
import numpy as np

D_MODEL = 1024
BATCH = 2
SEQ = 8192
DEPTH = 4

N_MEM = 256
N_A_LAYERS = DEPTH // 2
N_B_LAYERS = DEPTH - N_A_LAYERS
QBLOCK = 128

TOK_HEADS = 12
HEAD_DIM = 64
MEM_HEADS = 4
MEM_HEAD_DIM = 64
TOK_WIDTH = TOK_HEADS * HEAD_DIM
MEM_WIDTH = MEM_HEADS * MEM_HEAD_DIM
MIX_WIDTH = TOK_WIDTH + MEM_WIDTH

MLA_Q_RANK = 256
MLA_KV_RANK = 128
MLA_NOPE = 64
MLA_ROPE = 32
MLA_V = HEAD_DIM
ROPE_THETA = 10000.0
MLA_IN = MLA_Q_RANK + MLA_KV_RANK + MLA_ROPE + MEM_WIDTH

NSA_GROUPS = 2
NSA_HPG = TOK_HEADS // NSA_GROUPS
NSA_BRANCHES = 3
CMP_LEN = 32
CMP_STRIDE = 16
CMP_HIDDEN = 256
SEL_LEN = 64
SEL_TOPK = 16
WINDOW = 512
NSA_IN = TOK_WIDTH + TOK_HEADS * NSA_BRANCHES + MEM_WIDTH
NSA_KV = NSA_BRANCHES * 2 * NSA_GROUPS * HEAD_DIM

D_FF = 2816

DN_ALPHA = (2 * DEPTH) ** 0.25
DN_BETA = (8 * DEPTH) ** -0.25

LN_EPS = 1e-5
RMS_EPS = 1e-6
NEG = -1e30
FORCE_BONUS = 1e4

kernel_name = "yoco_mla_nsa_macaron_deepnorm_mem"


def layer_norm(x, g, b):
    xf = x.astype(jnp.float32)
    mu = jnp.mean(xf, -1, keepdims=True)
    var = jnp.mean(jnp.square(xf - mu), -1, keepdims=True)
    return ((xf - mu) * lax.rsqrt(var + LN_EPS) * g + b).astype(x.dtype)


def rms_norm(x, g):
    xf = x.astype(jnp.float32)
    return (xf * lax.rsqrt(jnp.mean(xf * xf, -1, keepdims=True) + RMS_EPS) * g).astype(x.dtype)


def masked_softmax(s, mask, axis=-1):
    s = jnp.where(mask, s.astype(jnp.float32), NEG)
    m = jnp.max(s, axis=axis, keepdims=True)
    e = jnp.exp(s - m) * mask
    return e / jnp.maximum(jnp.sum(e, axis=axis, keepdims=True), 1e-30)


def swiglu(x, w_gu, w_down):
    g, u = jnp.split(x @ w_gu, 2, axis=-1)
    return (jax.nn.silu(g) * u) @ w_down


def rope(x, pos):
    half = x.shape[-1] // 2
    freq = ROPE_THETA ** (-jnp.arange(half, dtype=jnp.float32) / half)
    ang = pos.astype(jnp.float32)[:, None] * freq[None, :]
    cos, sin = jnp.cos(ang), jnp.sin(ang)
    x1, x2 = x[..., :half], x[..., half:]
    return jnp.concatenate([x1 * cos - x2 * sin, x2 * cos + x1 * sin], -1).astype(x.dtype)


def alibi_slopes(n):
    def pow2(k):
        start = 2.0 ** (-8.0 / k)
        return [start ** (i + 1) for i in range(k)]
    if math.log2(n).is_integer():
        s = pow2(n)
    else:
        c = 2 ** math.floor(math.log2(n))
        s = pow2(c) + pow2(2 * c)[0::2][: n - c]
    return np.asarray(s, np.float32)


def memory_attention(q_mem, mem, w_mem_kv):
    B, T, _ = q_mem.shape
    M = mem.shape[1]
    k, v = jnp.split(mem @ w_mem_kv, 2, axis=-1)
    q = q_mem.reshape(B, T, MEM_HEADS, MEM_HEAD_DIM)
    k = k.reshape(B, M, MEM_HEADS, MEM_HEAD_DIM)
    v = v.reshape(B, M, MEM_HEADS, MEM_HEAD_DIM)
    s = jnp.einsum('bthd,bmhd->bhtm', q, k).astype(jnp.float32) * (MEM_HEAD_DIM ** -0.5)
    p = jax.nn.softmax(s, axis=-1).astype(v.dtype)
    return jnp.einsum('bhtm,bmhd->bthd', p, v).reshape(B, T, MEM_WIDTH)


def mla_mix(x, w_in, q_norm_g, kv_norm_g, w_uq, w_ukv, pos):
    B, T, _ = x.shape
    H = TOK_HEADS
    c_q, c_kv, k_r, q_mem = jnp.split(
        x @ w_in, [MLA_Q_RANK, MLA_Q_RANK + MLA_KV_RANK, MLA_Q_RANK + MLA_KV_RANK + MLA_ROPE], axis=-1)
    q = (rms_norm(c_q, q_norm_g) @ w_uq).reshape(B, T, H, MLA_NOPE + MLA_ROPE).transpose(0, 2, 1, 3)
    q = jnp.concatenate([q[..., :MLA_NOPE], rope(q[..., MLA_NOPE:], pos)], -1)
    kv = (rms_norm(c_kv, kv_norm_g) @ w_ukv).reshape(B, T, H, MLA_NOPE + MLA_V).transpose(0, 2, 1, 3)
    k_nope, v = kv[..., :MLA_NOPE], kv[..., MLA_NOPE:]
    k_r = rope(k_r, pos)
    k = jnp.concatenate([k_nope, jnp.broadcast_to(k_r[:, None], (B, H, T, MLA_ROPE))], -1)
    scale = (MLA_NOPE + MLA_ROPE) ** -0.5
    key_pos = jnp.arange(T)

    def block(c):
        t0 = c * QBLOCK
        tq = t0 + jnp.arange(QBLOCK)
        qb = lax.dynamic_slice_in_dim(q, t0, QBLOCK, axis=2)
        s = jnp.einsum('bhqd,bhkd->bhqk', qb, k) * scale
        p = masked_softmax(s, key_pos[None, :] <= tq[:, None]).astype(v.dtype)
        return jnp.einsum('bhqk,bhkd->bqhd', p, v)

    o = lax.map(block, jnp.arange(T // QBLOCK))
    o = o.transpose(1, 0, 2, 3, 4).reshape(B, T, TOK_WIDTH)
    return o, q_mem


def nsa_shared_kv(h, w_kv, cmp_pos, cmp_w1, cmp_b1, cmp_w2):
    B, T, _ = h.shape
    G = NSA_GROUPS
    kv = (h @ w_kv).reshape(B, T, NSA_BRANCHES, 2, G, HEAD_DIM).transpose(2, 3, 0, 4, 1, 5)
    n_cmp = (T - CMP_LEN) // CMP_STRIDE + 1
    idx = np.arange(n_cmp)[:, None] * CMP_STRIDE + np.arange(CMP_LEN)[None, :]

    def compress(z, j):
        blocks = z[:, :, idx] + cmp_pos[j]
        flat = blocks.reshape(B, G, n_cmp, CMP_LEN * HEAD_DIM)
        return jax.nn.gelu(flat @ cmp_w1[j] + cmp_b1[j]) @ cmp_w2[j]

    kc = compress(kv[0, 0], 0)
    vc = compress(kv[0, 1], 1)
    n_sel = T // SEL_LEN
    ks = kv[1, 0].reshape(B, G, n_sel, SEL_LEN, HEAD_DIM)
    vs = kv[1, 1].reshape(B, G, n_sel, SEL_LEN, HEAD_DIM)
    pad = ((0, 0), (0, 0), (WINDOW, 0), (0, 0))
    kw_pad = jnp.pad(kv[2, 0], pad)
    vw_pad = jnp.pad(kv[2, 1], pad)
    return kc, vc, ks, vs, kw_pad, vw_pad


def nsa_mix(x, w_in, kc, vc, ks, vs, kw_pad, vw_pad, slopes):
    B, T, _ = x.shape
    G, HPG = NSA_GROUPS, NSA_HPG
    q, gates, q_mem = jnp.split(x @ w_in, [TOK_WIDTH, TOK_WIDTH + TOK_HEADS * NSA_BRANCHES], axis=-1)
    q = q.reshape(B, T, G, HPG, HEAD_DIM).transpose(0, 2, 3, 1, 4)
    gates = jax.nn.sigmoid(gates.reshape(B, T, G, HPG, NSA_BRANCHES).transpose(0, 2, 3, 1, 4))
    m = slopes.reshape(G, HPG)[None, :, :, None, None]
    n_cmp = kc.shape[2]
    n_sel = ks.shape[2]
    topk = min(SEL_TOPK, n_sel)
    cmp_start = np.arange(n_cmp) * CMP_STRIDE
    cmp_end = jnp.asarray(cmp_start + CMP_LEN - 1)
    cmp_center = jnp.asarray(cmp_start + (CMP_LEN - 1) * 0.5, dtype=jnp.float32)
    sel_start = np.arange(n_sel) * SEL_LEN
    overlap = np.clip(np.minimum(cmp_start[:, None] + CMP_LEN, sel_start[None, :] + SEL_LEN)
                      - np.maximum(cmp_start[:, None], sel_start[None, :]), 0, None)
    agg = jnp.asarray(overlap / CMP_LEN, dtype=jnp.float32)
    blk = jnp.arange(n_sel)
    scale = HEAD_DIM ** -0.5
    gather = jax.vmap(jax.vmap(lambda blocks, i: blocks[i]))

    def block(c):
        t0 = c * QBLOCK
        tq = t0 + jnp.arange(QBLOCK)
        qb = lax.dynamic_slice_in_dim(q, t0, QBLOCK, axis=3)
        gb = lax.dynamic_slice_in_dim(gates, t0, QBLOCK, axis=3)
        dist_c = tq[:, None].astype(jnp.float32) - cmp_center[None, :]
        s_c = jnp.einsum('bghqd,bgnd->bghqn', qb, kc) * scale - m * dist_c
        p_c = masked_softmax(s_c, cmp_end[None, :] <= tq[:, None])
        o_c = jnp.einsum('bghqn,bgnd->bghqd', p_c.astype(vc.dtype), vc)
        imp = jnp.einsum('bghqn,nj->bgqj', p_c, agg)
        cur = tq // SEL_LEN
        forced = (blk[None] == 0) | (blk[None] == cur[:, None]) | (blk[None] == cur[:, None] - 1)
        imp = jnp.where(forced, imp + FORCE_BONUS, imp)
        imp = jnp.where(blk[None] * SEL_LEN <= tq[:, None], imp, NEG)
        _, sel = lax.top_k(imp, topk)
        k_sel = gather(ks, sel)
        v_sel = gather(vs, sel)
        pos_s = sel[..., None] * SEL_LEN + jnp.arange(SEL_LEN)
        dist_s = (tq[None, None, :, None, None] - pos_s)[:, :, None]
        s_s = jnp.einsum('bghqd,bgqkld->bghqkl', qb, k_sel) * scale - m[..., None] * dist_s
        p_s = masked_softmax(s_s, dist_s >= 0, axis=(-2, -1))
        o_s = jnp.einsum('bghqkl,bgqkld->bghqd', p_s.astype(v_sel.dtype), v_sel)
        kw = lax.dynamic_slice_in_dim(kw_pad, t0, WINDOW + QBLOCK, axis=2)
        vw = lax.dynamic_slice_in_dim(vw_pad, t0, WINDOW + QBLOCK, axis=2)
        pos_w = t0 - WINDOW + jnp.arange(WINDOW + QBLOCK)
        dist_w = tq[:, None] - pos_w[None, :]
        mask_w = (dist_w >= 0) & (dist_w < WINDOW) & (pos_w[None, :] >= 0)
        s_w = jnp.einsum('bghqd,bgkd->bghqk', qb, kw) * scale - m * dist_w
        p_w = masked_softmax(s_w, mask_w)
        o_w = jnp.einsum('bghqk,bgkd->bghqd', p_w.astype(vw.dtype), vw)
        o = gb[..., 0:1] * o_c + gb[..., 1:2] * o_s + gb[..., 2:3] * o_w
        return o.transpose(0, 3, 1, 2, 4).reshape(B, QBLOCK, TOK_WIDTH)

    o = lax.map(block, jnp.arange(T // QBLOCK))
    o = o.transpose(1, 0, 2, 3).reshape(B, T, TOK_WIDTH)
    return o, q_mem


def setup_inputs(seed: int = 0) -> dict:
    key = jax.random.key(seed)
    ks = jax.random.split(key, 20)

    def nrm(k, shape, fan_in, gain=1.0):
        return jax.random.normal(k, shape, jnp.float32) * (gain * fan_in ** -0.5)

    def gain(k, shape):
        return 1.0 + 0.02 * jax.random.normal(k, shape, jnp.float32)

    return {
        "x": jax.random.normal(ks[0], (BATCH, SEQ, D_MODEL), jnp.float32),
        "mem": jax.random.normal(ks[1], (BATCH, N_MEM, D_MODEL), jnp.float32),
        "ln_g": gain(ks[2], (DEPTH, 3, D_MODEL)),
        "ln_b": 0.02 * jax.random.normal(ks[3], (DEPTH, 3, D_MODEL), jnp.float32),
        "ffn_w_gu": nrm(ks[4], (DEPTH, 2, D_MODEL, 2 * D_FF), D_MODEL),
        "ffn_w_down": nrm(ks[5], (DEPTH, 2, D_FF, D_MODEL), D_FF, DN_BETA),
        "w_mem_kv": nrm(ks[6], (DEPTH, D_MODEL, 2 * MEM_WIDTH), D_MODEL),
        "w_out": nrm(ks[7], (DEPTH, MIX_WIDTH, D_MODEL), MIX_WIDTH, DN_BETA),
        "mla_w_in": nrm(ks[8], (N_A_LAYERS, D_MODEL, MLA_IN), D_MODEL),
        "mla_q_norm_g": gain(ks[9], (N_A_LAYERS, MLA_Q_RANK)),
        "mla_kv_norm_g": gain(ks[10], (N_A_LAYERS, MLA_KV_RANK)),
        "mla_w_uq": nrm(ks[11], (N_A_LAYERS, MLA_Q_RANK, TOK_HEADS * (MLA_NOPE + MLA_ROPE)), MLA_Q_RANK),
        "mla_w_ukv": nrm(ks[12], (N_A_LAYERS, MLA_KV_RANK, TOK_HEADS * (MLA_NOPE + MLA_V)), MLA_KV_RANK),
        "nsa_w_in": nrm(ks[13], (N_B_LAYERS, D_MODEL, NSA_IN), D_MODEL),
        "nsa_w_kv": nrm(ks[14], (D_MODEL, NSA_KV), D_MODEL),
        "cmp_pos": 0.1 * jax.random.normal(ks[15], (2, CMP_LEN, HEAD_DIM), jnp.float32),
        "cmp_w1": nrm(ks[16], (2, CMP_LEN * HEAD_DIM, CMP_HIDDEN), CMP_LEN * HEAD_DIM),
        "cmp_b1": 0.02 * jax.random.normal(ks[17], (2, CMP_HIDDEN), jnp.float32),
        "cmp_w2": nrm(ks[18], (2, CMP_HIDDEN, HEAD_DIM), CMP_HIDDEN),
    }


def reference(x, mem, ln_g, ln_b, ffn_w_gu, ffn_w_down, w_mem_kv, w_out,
              mla_w_in, mla_q_norm_g, mla_kv_norm_g, mla_w_uq, mla_w_ukv,
              nsa_w_in, nsa_w_kv, cmp_pos, cmp_w1, cmp_b1, cmp_w2):
    T = x.shape[1]
    pos = jnp.arange(T)
    slopes = jnp.asarray(alibi_slopes(TOK_HEADS))
    shared = None
    for layer in range(DEPTH):
        x = layer_norm(DN_ALPHA * x + 0.5 * swiglu(x, ffn_w_gu[layer, 0], ffn_w_down[layer, 0]),
                       ln_g[layer, 0], ln_b[layer, 0])
        if layer < N_A_LAYERS:
            o_tok, q_mem = mla_mix(x, mla_w_in[layer], mla_q_norm_g[layer], mla_kv_norm_g[layer],
                                   mla_w_uq[layer], mla_w_ukv[layer], pos)
        else:
            b = layer - N_A_LAYERS
            kc, vc, ks_, vs_, kw_pad, vw_pad = shared
            o_tok, q_mem = nsa_mix(x, nsa_w_in[b], kc, vc, ks_, vs_, kw_pad, vw_pad, slopes)
        o_mem = memory_attention(q_mem, mem, w_mem_kv[layer])
        mix = jnp.concatenate([o_tok, o_mem], axis=-1) @ w_out[layer]
        x = layer_norm(DN_ALPHA * x + mix, ln_g[layer, 1], ln_b[layer, 1])
        x = layer_norm(DN_ALPHA * x + 0.5 * swiglu(x, ffn_w_gu[layer, 1], ffn_w_down[layer, 1]),
                       ln_g[layer, 2], ln_b[layer, 2])
        if layer == N_A_LAYERS - 1:
            shared = nsa_shared_kv(x, nsa_w_kv, cmp_pos, cmp_w1, cmp_b1, cmp_w2)
    return x
```

```cpp
#include <hip/hip_runtime.h>
#include <hip/hip_cooperative_groups.h>
#include <cstdio>
#include <cstdint>
namespace cg = cooperative_groups;
#ifndef ABL_SEL
#define ABL_SEL 1.f
#endif
#ifndef ABL_CMP
#define ABL_CMP 1.f
#endif
#ifndef ABL_WIN
#define ABL_WIN 1.f
#endif
#ifndef ABL_MEM
#define ABL_MEM 1.f
#endif
#ifndef ABL_MLA
#define ABL_MLA 1.f
#endif
namespace pg8 {
#define PG8_LAS __attribute__((address_space(3)))
typedef unsigned short bf16_t;
typedef short bf16x8 __attribute__((ext_vector_type(8)));
typedef float f32x4 __attribute__((ext_vector_type(4)));
typedef unsigned u32x4 __attribute__((ext_vector_type(4)));
constexpr int BM = 256, BK = 64, HALF = 128, HTB = HALF * BK * 2  , STAGE_BYTES = 8 * HTB, NXCD = 8, WGM = 8;

__host__ __device__ __forceinline__ int lds_byte(int r, int c) { const int st = (r >> 4) * 2 + (c >> 5), rr = r & 15, cc = c & 31, ob = rr * 64 + cc * 2; return st * 1024 + (ob ^ (((ob >> 9) & 1) << 5)); }
__host__ __device__ __forceinline__ void stage_rc(int b, int& R, int& C) { const int st = b / 1024, sb = b % 1024, swz = sb ^ (((sb >> 9) & 1) << 5); R = (st >> 1) * 16 + swz / 64; C = (st & 1) * 32 + (swz % 64) / 2; }
__host__ __device__ __forceinline__ int perm32(int rho) { const int n = rho >> 4, i = rho & 15; return 8 * (i >> 2) + 4 * n + (i & 3); }

struct Unit { int pm, pn; };
struct Gemm { const bf16_t* A; const bf16_t* Bt; int M, N, K, lda; };

struct StaticOrder {
    int nM, nN, nwg, G, c;
    __host__ __device__ void init(int M, int N, int G_, int c_) { nM = M / BM; nN = N / BM; nwg = nM * nN; G = G_; c = c_; }
    __host__ __device__ bool next(int i, Unit& u) const {
        const long L = (long)i * G + c; if (L >= nwg) return false;
        int wgid = (int)L; { const int q = nwg / NXCD, r = nwg % NXCD, xcd = wgid % NXCD, off = wgid / NXCD; wgid = (xcd < r ? xcd * (q + 1) : r * (q + 1) + (xcd - r) * q) + off; }
        const int nig = WGM * nN, gid = wgid / nig, fm = gid * WGM, gsz = (nM - fm) < WGM ? (nM - fm) : WGM;
        u.pm = fm + ((wgid % nig) % gsz); u.pn = (wgid % nig) / gsz; return true;
    }
    __device__ __forceinline__ void a_ready(const Unit&) const {}
    __device__ __forceinline__ void done(const Unit&) const {}
};

typedef _Float16 h16x2 __attribute__((ext_vector_type(2))); typedef _Float16 h16x8 __attribute__((ext_vector_type(8))); typedef float f32x2c __attribute__((ext_vector_type(2)));
__device__ __forceinline__ unsigned cvt_pk_bf16(float lo, float hi) { const f32x2c v = {lo, hi}; const h16x2 h = __builtin_convertvector(v, h16x2); return __builtin_bit_cast(unsigned, h); }
typedef float f32x2 __attribute__((ext_vector_type(2)));
typedef float f32x2 __attribute__((ext_vector_type(2)));
__device__ __forceinline__ float fexp2(float x) { return __builtin_amdgcn_exp2f(x); }
__device__ __forceinline__ float frcp(float x) { return __builtin_amdgcn_rcpf(x); }
__device__ __forceinline__ float sigmoidf_(float x) { return frcp(1.f + fexp2(-1.4426950408889634f * x)); }
__device__ __forceinline__ u32x4 pack8(f32x4 a, f32x4 b) { u32x4 w; w.x = cvt_pk_bf16(a[0], a[1]); w.y = cvt_pk_bf16(a[2], a[3]); w.z = cvt_pk_bf16(b[0], b[1]); w.w = cvt_pk_bf16(b[2], b[3]); return w; }
typedef unsigned u32x2 __attribute__((ext_vector_type(2)));
enum { EP_SWIGLU = 0, EP_RESID = 1, EP_F32 = 2, EP_UQ = 3, EP_UKV = 4, EP_NSAIN = 5, EP_KV = 6, EP_C1 = 7, EP_C2 = 8, EP_MEMKV = 9 };
struct Epi {
    static constexpr bool PERM = true, AFTER_DRAIN = false;
    int mode; bf16_t* o0; bf16_t* o1; float* of; const float* fin; float s0, s1;
    __device__ __forceinline__ void operator()(const f32x4 (&acc)[2][2][4][2], const Unit& u, int wr, int wc, int fr, int fq) const {
        const int rowb = u.pm * BM + wr * 64 + fr;
        const int lc = wc * 32 + 8 * fq;
        if (mode == EP_SWIGLU) {
#pragma unroll
            for (int ai = 0; ai < 2; ++ai)
#pragma unroll
                for (int m = 0; m < 4; ++m) { const size_t row = rowb + ai * HALF + m * 16;
                    f32x4 r[2];
#pragma unroll
                    for (int n = 0; n < 2; ++n) { const f32x4 g = acc[ai][0][m][n], uu = acc[ai][1][m][n];
#pragma unroll
                        for (int i = 0; i < 4; ++i) r[n][i] = g[i] * sigmoidf_(g[i]) * uu[i]; }
                    *(u32x4*)(o0 + row * 2816 + u.pn * 128 + lc) = pack8(r[0], r[1]); }
        } else if (mode == EP_RESID) {
#pragma unroll
            for (int ai = 0; ai < 2; ++ai)
#pragma unroll
                for (int m = 0; m < 4; ++m)
#pragma unroll
                    for (int bj = 0; bj < 2; ++bj) { const size_t off = (size_t)(rowb + ai * HALF + m * 16) * 1024 + u.pn * BM + bj * HALF + lc;
                        const f32x4 b0 = *(const f32x4*)(fin + off), b1 = *(const f32x4*)(fin + off + 4);
                        *(f32x4*)(of + off) = b0 * s0 + acc[ai][bj][m][0] * s1; *(f32x4*)(of + off + 4) = b1 * s0 + acc[ai][bj][m][1] * s1; }
        } else if (mode == EP_F32) {
#pragma unroll
            for (int ai = 0; ai < 2; ++ai)
#pragma unroll
                for (int m = 0; m < 4; ++m)
#pragma unroll
                    for (int bj = 0; bj < 2; ++bj) { const size_t off = (size_t)(rowb + ai * HALF + m * 16) * 768 + u.pn * BM + bj * HALF + lc;
                        *(f32x4*)(of + off) = acc[ai][bj][m][0]; *(f32x4*)(of + off + 4) = acc[ai][bj][m][1]; }
        } else if (mode == EP_UQ) {
            if (u.pn < 3) {
#pragma unroll
                for (int ai = 0; ai < 2; ++ai)
#pragma unroll
                    for (int m = 0; m < 4; ++m)
#pragma unroll
                        for (int bj = 0; bj < 2; ++bj) { const int c = u.pn * BM + bj * HALF + lc; const int h = c >> 6, d = c & 63;
                            *(u32x4*)(o0 + (size_t)(rowb + ai * HALF + m * 16) * 1152 + h * 96 + d) = pack8(acc[ai][bj][m][0] * s0, acc[ai][bj][m][1] * s0); }
            } else {
                const int h = (u.pn - 3) * 8 + (lc >> 4), j0 = lc & 15;
                if (h < 12) {
#pragma unroll
                    for (int ai = 0; ai < 2; ++ai)
#pragma unroll
                        for (int m = 0; m < 4; ++m) { const int row = rowb + ai * HALF + m * 16; const int pos = row & 8191;
                            const float* cs = fin + ((size_t)pos * 16 + j0) * 2;
                            f32x4 o1v[2], o2v[2];
#pragma unroll
                            for (int n = 0; n < 2; ++n) { const f32x4 x1 = acc[ai][0][m][n], x2 = acc[ai][1][m][n];
                                const f32x4 ca = *(const f32x4*)(cs + n * 8), cb = *(const f32x4*)(cs + n * 8 + 4);
                                const float co[4] = {ca[0], ca[2], cb[0], cb[2]}, si[4] = {ca[1], ca[3], cb[1], cb[3]};
#pragma unroll
                                for (int i = 0; i < 4; ++i) { o1v[n][i] = (x1[i] * co[i] - x2[i] * si[i]) * s0; o2v[n][i] = (x2[i] * co[i] + x1[i] * si[i]) * s0; } }
                            bf16_t* qp = o0 + (size_t)row * 1152 + h * 96 + 64 + j0;
                            *(u32x4*)(qp) = pack8(o1v[0], o1v[1]); *(u32x4*)(qp + 16) = pack8(o2v[0], o2v[1]); }
                }
            }
        } else if (mode == EP_UKV) {
#pragma unroll
            for (int ai = 0; ai < 2; ++ai)
#pragma unroll
                for (int m = 0; m < 4; ++m)
#pragma unroll
                    for (int bj = 0; bj < 2; ++bj) { const int h = u.pn * 2 + bj; bf16_t* dst = (lc < 64) ? (o0 + h * 64 + lc) : (o1 + h * 64 + lc - 64);
                        *(u32x4*)(dst + (size_t)(rowb + ai * HALF + m * 16) * 768) = pack8(acc[ai][bj][m][0], acc[ai][bj][m][1]); }
        } else if (mode == EP_NSAIN) {
#pragma unroll
            for (int ai = 0; ai < 2; ++ai)
#pragma unroll
                for (int m = 0; m < 4; ++m)
#pragma unroll
                    for (int bj = 0; bj < 2; ++bj) { const size_t row = rowb + ai * HALF + m * 16; const int c = bj * HALF + lc;
                        if (u.pn < 3) *(u32x4*)(o0 + row * 768 + u.pn * BM + c) = pack8(acc[ai][bj][m][0] * s0, acc[ai][bj][m][1] * s0);
                        else if (u.pn == 3) *(u32x4*)(o1 + row * 256 + c) = pack8(acc[ai][bj][m][0] * s0, acc[ai][bj][m][1] * s0);
                        else if (c < 40) {
#pragma unroll
                            for (int n = 0; n < 2; ++n)
#pragma unroll
                                for (int i = 0; i < 4; ++i) if (c + 4 * n + i < 36) of[row * 64 + c + 4 * n + i] = sigmoidf_(acc[ai][bj][m][n][i]); } }
        } else if (mode == EP_KV) {
#pragma unroll
            for (int ai = 0; ai < 2; ++ai)
#pragma unroll
                for (int m = 0; m < 4; ++m)
#pragma unroll
                    for (int bj = 0; bj < 2; ++bj) { const int row = rowb + ai * HALF + m * 16; const int c = u.pn * BM + bj * HALF + lc;
                        const int chunk = c >> 6, d = c & 63, b = row >> 13, t = row & 8191;
                        const size_t dst = ((((size_t)(chunk >> 1) * 2 + b) * 2 + (chunk & 1)) * 8192 + t) * 64 + d;
                        *(u32x4*)(o0 + dst) = pack8(acc[ai][bj][m][0], acc[ai][bj][m][1]); }
        } else if (mode == EP_C1) {
#pragma unroll
            for (int ai = 0; ai < 2; ++ai)
#pragma unroll
                for (int m = 0; m < 4; ++m)
#pragma unroll
                    for (int bj = 0; bj < 2; ++bj) { const size_t row = rowb + ai * HALF + m * 16; const int c = bj * HALF + lc;
                        f32x4 r[2];
#pragma unroll
                        for (int n = 0; n < 2; ++n) { const f32x4 bv = *(const f32x4*)(fin + c + 4 * n);
#pragma unroll
                            for (int i = 0; i < 4; ++i) { const float v = acc[ai][bj][m][n][i] + bv[i]; r[n][i] = v * sigmoidf_(1.5957691216057308f * (v + 0.044715f * v * v * v)); } }
                        *(u32x4*)(o0 + row * 256 + c) = pack8(r[0], r[1]); }
        } else if (mode == EP_C2) {
            if (lc < 64) {
#pragma unroll
                for (int ai = 0; ai < 2; ++ai)
#pragma unroll
                    for (int m = 0; m < 4; ++m) { const int row = rowb + ai * HALF + m * 16;
                        u32x4 w = pack8(acc[ai][0][m][0], acc[ai][0][m][1]); if ((row & 511) == 511) w = (u32x4){0u, 0u, 0u, 0u};
                        *(u32x4*)(o0 + (size_t)row * 64 + lc) = w; }
            }
        } else {
#pragma unroll
            for (int ai = 0; ai < 2; ++ai)
#pragma unroll
                for (int m = 0; m < 4; ++m)
#pragma unroll
                    for (int bj = 0; bj < 2; ++bj) { const int row = rowb + ai * HALF + m * 16; const int c = u.pn * BM + bj * HALF + lc;
                        const int layer = c >> 9, kvi = (c >> 8) & 1, h = (c >> 6) & 3, d = c & 63, b = row >> 8, mi = row & 255;
                        const size_t dst = (((((size_t)layer * 2 + kvi) * 2 + b) * 4 + h) * 256 + mi) * 64 + d;
                        *(u32x4*)(o0 + dst) = pack8(acc[ai][bj][m][0], acc[ai][bj][m][1]); }
        }
    }
};
template <class Epi, class Sched, bool ALIGN_EPI = false, bool SP2 = false>
__device__ __forceinline__ void gemm_phase(PG8_LAS unsigned char* lds, const Gemm g, const Sched& S, const Epi& E) {
    int tid_ = threadIdx.x; asm volatile("" : "+v"(tid_));
    const int tid = tid_, wid = __builtin_amdgcn_readfirstlane(tid >> 6), lane = tid & 63, wr = wid >> 2, wc = wid & 3, fr = lane & 15, fq = lane >> 4;
    const int K = g.K, nt = K / BK;
    unsigned voffA[2], voffB[2];
#pragma unroll
    for (int i = 0; i < 2; ++i) { int R, C; stage_rc(tid * 16 + i * 8192, R, C); const int Rb = Epi::PERM ? ((R & ~31) + perm32(R & 31)) : R;
        voffA[i] = (unsigned)(R * g.lda + C) * 2u; voffB[i] = (unsigned)(Rb * K + C) * 2u; }
    const size_t kstep = (size_t)(BK * 2);
    const size_t hstepA = (size_t)HALF * g.lda * 2, hstepB = (size_t)HALF * K * 2;
    const size_t tstepA = 2 * hstepA, tstepB = 2 * hstepB;
    const unsigned ldsw = (unsigned)wid * 1024u;
    const int aoff = lds_byte(wr * 64 + fr, fq * 8), boff = lds_byte(wc * 32 + fr, fq * 8);
#define PG8_SA(b, h) (((b) * 2 + (h)) * HTB)
#define PG8_SB(b, h) ((4 + (b) * 2 + (h)) * HTB)
#define PG8_STAGE(bufoff, gbase, voff) do { _Pragma("unroll") for (int _i = 0; _i < 2; ++_i) \
        __builtin_amdgcn_global_load_lds((const unsigned*)((const char*)(gbase) + (voff)[_i]), (PG8_LAS unsigned*)(lds + (bufoff) + ldsw + _i * 8192), 16, 0, 0); } while (0)
#define PG8_LDA(dst, b, h) do { _Pragma("unroll") for (int m = 0; m < 4; ++m) _Pragma("unroll") for (int k = 0; k < 2; ++k) dst[m][k] = *(const PG8_LAS bf16x8*)(lds + PG8_SA(b, h) + aoff + m * 2048 + k * 1024); } while (0)
#define PG8_LDB(dst, b, h) do { _Pragma("unroll") for (int n = 0; n < 2; ++n) _Pragma("unroll") for (int k = 0; k < 2; ++k) dst[n][k] = *(const PG8_LAS bf16x8*)(lds + PG8_SB(b, h) + boff + n * 2048 + k * 1024); } while (0)
#define PG8_MMA(ai, bj, At, Bt) do { __builtin_amdgcn_s_setprio(1); _Pragma("unroll") for (int m = 0; m < 4; ++m) _Pragma("unroll") for (int n = 0; n < 2; ++n) _Pragma("unroll") for (int k = 0; k < 2; ++k) \
        acc[ai][bj][m][n] = __builtin_amdgcn_mfma_f32_16x16x32_f16(__builtin_bit_cast(h16x8, Bt[n][k]), __builtin_bit_cast(h16x8, At[m][k]), acc[ai][bj][m][n], 0, 0, 0); __builtin_amdgcn_s_setprio(0); } while (0)
#define PG8_WAIT_V(n) asm volatile("s_waitcnt vmcnt(" #n ")" ::: "memory")
#define PG8_WAIT_L(n) asm volatile("s_waitcnt lgkmcnt(" #n ")" ::: "memory")
#define PG8_BAR __builtin_amdgcn_s_barrier()
#define PG8_SCHED __builtin_amdgcn_sched_barrier(0)
    Unit cur, nxt; int ui = 0;
    if (!S.next(0, cur)) return;
    f32x4 acc[2][2][4][2];
#pragma unroll
    for (int a = 0; a < 2; ++a)
#pragma unroll
        for (int b = 0; b < 2; ++b)
#pragma unroll
            for (int m = 0; m < 4; ++m)
#pragma unroll
                for (int n = 0; n < 2; ++n) acc[a][b][m][n] = (f32x4){0.f, 0.f, 0.f, 0.f};
    bf16x8 At[4][2], B0[2][2], B1[2][2];
    const char* cA = (const char*)g.A + (size_t)cur.pm * tstepA; const char* cB = (const char*)g.Bt + (size_t)cur.pn * tstepB;
    S.a_ready(cur);
    if constexpr (SP2) {
        PG8_STAGE(PG8_SB(0, 0), cB, voffB); PG8_STAGE(PG8_SB(0, 1), cB + hstepB, voffB); PG8_STAGE(PG8_SA(0, 0), cA, voffA); PG8_STAGE(PG8_SA(0, 1), cA + hstepA, voffA);
        if (wr == 1) PG8_BAR;
        PG8_WAIT_V(2); PG8_BAR;
        PG8_STAGE(PG8_SB(1, 0), cB + kstep, voffB); PG8_STAGE(PG8_SA(1, 0), cA + kstep, voffA); PG8_STAGE(PG8_SB(1, 1), cB + hstepB + kstep, voffB);
        PG8_WAIT_V(6); PG8_BAR;
    } else {
        PG8_STAGE(PG8_SB(0, 0), cB, voffB); PG8_STAGE(PG8_SA(0, 0), cA, voffA); PG8_STAGE(PG8_SB(0, 1), cB + hstepB, voffB); PG8_STAGE(PG8_SA(0, 1), cA + hstepA, voffA);
        if (wr == 1) PG8_BAR;
        PG8_WAIT_V(4); PG8_BAR;
        PG8_STAGE(PG8_SB(1, 0), cB + kstep, voffB); PG8_STAGE(PG8_SA(1, 0), cA + kstep, voffA); PG8_STAGE(PG8_SB(1, 1), cB + hstepB + kstep, voffB);
        PG8_WAIT_V(6); PG8_BAR;
    }
    for (;;) {
        const bool has_next = S.next(ui + 1, nxt);
        const char* nA = has_next ? (const char*)g.A + (size_t)nxt.pm * tstepA : cA; const char* nB = has_next ? (const char*)g.Bt + (size_t)nxt.pn * tstepB : cB;
        for (int t = 0; t < nt; t += 2) {
            const bool last = (t == nt - 2);
            const char* a1 = cA + (size_t)(t + 1) * kstep;
            const char* a2 = last ? nA : cA + (size_t)(t + 2) * kstep; const char* b2 = last ? nB : cB + (size_t)(t + 2) * kstep;
            const char* a3 = a2 + kstep; const char* b3 = b2 + kstep;
            if (last && has_next) S.a_ready(nxt);
            if constexpr (SP2) {
            PG8_LDB(B0, 0, 0); PG8_LDB(B1, 0, 1); PG8_SCHED; PG8_LDA(At, 0, 0); PG8_STAGE(PG8_SA(1, 1), a1 + hstepA, voffA);
            PG8_WAIT_V(8); PG8_WAIT_L(0); PG8_BAR; PG8_MMA(0, 0, At, B0); PG8_MMA(0, 1, At, B1); PG8_BAR; PG8_SCHED;
            PG8_LDA(At, 0, 1); PG8_STAGE(PG8_SB(0, 0), b2, voffB); PG8_STAGE(PG8_SB(0, 1), b2 + hstepB, voffB); PG8_STAGE(PG8_SA(0, 0), a2, voffA);
            PG8_WAIT_V(8); PG8_WAIT_L(0); PG8_BAR; PG8_MMA(1, 0, At, B0); PG8_MMA(1, 1, At, B1); PG8_BAR; PG8_SCHED;
            PG8_LDB(B0, 1, 0); PG8_LDB(B1, 1, 1); PG8_SCHED; PG8_LDA(At, 1, 0); PG8_STAGE(PG8_SA(0, 1), a2 + hstepA, voffA);
            PG8_WAIT_V(8); PG8_WAIT_L(0); PG8_BAR; PG8_MMA(0, 0, At, B0); PG8_MMA(0, 1, At, B1); PG8_BAR; PG8_SCHED;
            PG8_LDA(At, 1, 1); PG8_STAGE(PG8_SB(1, 0), b3, voffB); PG8_STAGE(PG8_SB(1, 1), b3 + hstepB, voffB); PG8_STAGE(PG8_SA(1, 0), a3, voffA);
            PG8_WAIT_V(8); PG8_WAIT_L(0); PG8_BAR; PG8_MMA(1, 0, At, B0); PG8_MMA(1, 1, At, B1); PG8_BAR; PG8_SCHED;
            } else {
            PG8_LDB(B0, 0, 0); PG8_SCHED; PG8_LDA(At, 0, 0); PG8_STAGE(PG8_SA(1, 1), a1 + hstepA, voffA);
            PG8_WAIT_L(8); PG8_BAR; PG8_WAIT_L(0); PG8_MMA(0, 0, At, B0); PG8_BAR; PG8_SCHED;
            PG8_LDB(B1, 0, 1); PG8_STAGE(PG8_SB(0, 0), b2, voffB);
            PG8_BAR; PG8_WAIT_L(0); PG8_MMA(0, 1, At, B1); PG8_BAR;
            PG8_LDA(At, 0, 1); PG8_STAGE(PG8_SA(0, 0), a2, voffA);
            PG8_BAR; PG8_WAIT_L(0); PG8_MMA(1, 0, At, B0); PG8_BAR; PG8_SCHED;
            PG8_STAGE(PG8_SB(0, 1), b2 + hstepB, voffB);
            PG8_WAIT_V(6); PG8_BAR; PG8_MMA(1, 1, At, B1); PG8_BAR;
            PG8_LDB(B0, 1, 0); PG8_SCHED; PG8_LDA(At, 1, 0); PG8_STAGE(PG8_SA(0, 1), a2 + hstepA, voffA);
            PG8_WAIT_L(8); PG8_BAR; PG8_WAIT_L(0); PG8_MMA(0, 0, At, B0); PG8_BAR; PG8_SCHED;
            PG8_LDB(B1, 1, 1); PG8_STAGE(PG8_SB(1, 0), b3, voffB);
            PG8_BAR; PG8_WAIT_L(0); PG8_MMA(0, 1, At, B1); PG8_BAR;
            PG8_LDA(At, 1, 1); PG8_STAGE(PG8_SA(1, 0), a3, voffA);
            PG8_BAR; PG8_WAIT_L(0); PG8_MMA(1, 0, At, B0); PG8_BAR; PG8_SCHED;
            PG8_STAGE(PG8_SB(1, 1), b3 + hstepB, voffB);
            PG8_WAIT_V(6); PG8_BAR; PG8_MMA(1, 1, At, B1); PG8_BAR;
            }
        }
        if constexpr (ALIGN_EPI) { if (wr == 0) PG8_BAR; }
        if constexpr (!Epi::AFTER_DRAIN) { E(acc, cur, wr, wc, fr, fq); S.done(cur); }
        if (!has_next) break;
#pragma unroll
        for (int a = 0; a < 2; ++a)
#pragma unroll
            for (int b = 0; b < 2; ++b)
#pragma unroll
                for (int m = 0; m < 4; ++m)
#pragma unroll
                    for (int n = 0; n < 2; ++n) acc[a][b][m][n] = (f32x4){0.f, 0.f, 0.f, 0.f};
        cur = nxt; cA = nA; cB = nB; ++ui;
        if constexpr (ALIGN_EPI) { if (wr == 1) PG8_BAR; }
    }
    PG8_WAIT_V(0);
    if constexpr (!ALIGN_EPI) { if (wr == 0) PG8_BAR; }
    PG8_BAR;
    if constexpr (Epi::AFTER_DRAIN) { E.fused(acc, cur, wr, wc, fr, fq, lds, wid, lane); S.done(cur); }
#undef PG8_SA
#undef PG8_SB
#undef PG8_STAGE
#undef PG8_LDA
#undef PG8_LDB
#undef PG8_MMA
#undef PG8_WAIT_V
#undef PG8_WAIT_L
#undef PG8_BAR
#undef PG8_SCHED
}
}
#define LAS __attribute__((address_space(3)))
typedef unsigned short bf16_t;
typedef short bf16x8 __attribute__((ext_vector_type(8)));
typedef float f32x4 __attribute__((ext_vector_type(4)));
typedef float f32x16 __attribute__((ext_vector_type(16)));
typedef unsigned u32x4 __attribute__((ext_vector_type(4)));
typedef unsigned u32x2 __attribute__((ext_vector_type(2)));
using pg8::cvt_pk_bf16; using pg8::fexp2; using pg8::frcp;
#define CR(r) (((r) & 3) + 8 * ((r) >> 2))
constexpr float LOG2E = 1.4426950408889634f;
constexpr int VS = 144;
constexpr int ABUF = 24576;
constexpr int AVOFF = 13312;
struct ASt { f32x16 o0, o1; float m, l; };
struct TReg { u32x4 k0, k1, v; };

template <bool ROPE> __device__ __forceinline__ void tile_load(TReg& R, const bf16_t* Kp, int pitchK, const bf16_t* KRp, const bf16_t* Vp, int pitchV, int tid) {
    const int key = tid >> 3, c = tid & 7;
    R.k0 = *(const u32x4*)(Kp + (size_t)key * pitchK + c * 8);
    R.v = *(const u32x4*)(Vp + (size_t)key * pitchV + c * 8);
    if (ROPE) { if (tid < 256) R.k1 = *(const u32x4*)(KRp + (size_t)(tid >> 2) * 32 + (tid & 3) * 8); }
}
template <int DQK> __device__ __forceinline__ void tile_store(const TReg& R, LAS unsigned char* buf, int tid) {
    constexpr int KS = DQK * 2 + 16;
    const int key = tid >> 3, c = tid & 7;
    *(LAS u32x4*)(buf + key * KS + c * 16) = R.k0;
    if (DQK == 96) { if (tid < 256) *(LAS u32x4*)(buf + (tid >> 2) * KS + 128 + (tid & 3) * 16) = R.k1; }
    const int k32 = key & 31, pos = (key & 32) + ((k32 >> 2) & 1) * 16 + ((k32 & 3) | ((k32 >> 3) << 2));
    LAS unsigned char* vt = buf + AVOFF + (c * 8) * VS + pos * 2;
    const unsigned w[4] = {R.v.x, R.v.y, R.v.z, R.v.w};
#pragma unroll
    for (int i = 0; i < 4; ++i) { *(LAS unsigned short*)(vt + (2 * i) * VS) = (unsigned short)(w[i] & 0xffffu); *(LAS unsigned short*)(vt + (2 * i + 1) * VS) = (unsigned short)(w[i] >> 16); }
}
template <int DQK> __device__ __forceinline__ void qk_tile(const LAS unsigned char* Kb, const bf16x8 (&qr)[DQK / 16], f32x16& s0, f32x16& s1, int r32, int hi) {
    constexpr int KS = DQK * 2 + 16;
    const LAS unsigned char* p = Kb + r32 * KS + hi * 16;
#pragma unroll
    for (int d0 = 0; d0 < DQK / 16; ++d0) {
        const bf16x8 a0 = *(const LAS bf16x8*)(p + d0 * 32), a1 = *(const LAS bf16x8*)(p + 32 * KS + d0 * 32);
        s0 = __builtin_amdgcn_mfma_f32_32x32x16_f16(__builtin_bit_cast(pg8::h16x8, a0), __builtin_bit_cast(pg8::h16x8, qr[d0]), s0, 0, 0, 0);
        s1 = __builtin_amdgcn_mfma_f32_32x32x16_f16(__builtin_bit_cast(pg8::h16x8, a1), __builtin_bit_cast(pg8::h16x8, qr[d0]), s1, 0, 0, 0);
    }
}
__device__ __forceinline__ void bias_init(f32x16& s0, f32x16& s1, float se, float sb) {
#pragma unroll
    for (int r = 0; r < 16; ++r) { s0[r] = se * (float)CR(r) + sb; s1[r] = se * (float)(CR(r) + 32) + sb; }
}
__device__ __forceinline__ void mask_tile(f32x16& s0, f32x16& s1, int lim, int lim2) {
#pragma unroll
    for (int r = 0; r < 16; ++r) {
        if (!(CR(r) <= lim && CR(r) > lim2)) s0[r] = -INFINITY;
        if (!(CR(r) + 32 <= lim && CR(r) + 32 > lim2)) s1[r] = -INFINITY;
    }
}
__device__ __forceinline__ bf16x8 pack_p(const f32x16& s, int b) {
    u32x4 w; w.x = cvt_pk_bf16(s[b], s[b + 1]); w.y = cvt_pk_bf16(s[b + 2], s[b + 3]); w.z = cvt_pk_bf16(s[b + 4], s[b + 5]); w.w = cvt_pk_bf16(s[b + 6], s[b + 7]);
    return __builtin_bit_cast(bf16x8, w);
}
__device__ __forceinline__ void pv_tile(f32x16& o0, f32x16& o1, const f32x16& s0, const f32x16& s1, const LAS unsigned char* VT, int r32, int hi) {
    const LAS unsigned char* vp = VT + r32 * VS + hi * 32;
    const bf16x8 p0 = pack_p(s0, 0), p1 = pack_p(s0, 8), p2 = pack_p(s1, 0), p3 = pack_p(s1, 8);
#define PV1(k4, P) { const bf16x8 v0 = *(const LAS bf16x8*)(vp + ((k4) >> 1) * 64 + ((k4) & 1) * 16), v1 = *(const LAS bf16x8*)(vp + 32 * VS + ((k4) >> 1) * 64 + ((k4) & 1) * 16); \
        o0 = __builtin_amdgcn_mfma_f32_32x32x16_f16(__builtin_bit_cast(pg8::h16x8, v0), __builtin_bit_cast(pg8::h16x8, P), o0, 0, 0, 0); o1 = __builtin_amdgcn_mfma_f32_32x32x16_f16(__builtin_bit_cast(pg8::h16x8, v1), __builtin_bit_cast(pg8::h16x8, P), o1, 0, 0, 0); }
    PV1(0, p0) PV1(1, p1) PV1(2, p2) PV1(3, p3)
#undef PV1
}
__device__ __forceinline__ float rowmax32(const f32x16& s0, const f32x16& s1) {
    float mx = fmaxf(s0[0], s1[0]);
#pragma unroll
    for (int r = 1; r < 16; ++r) mx = fmaxf(mx, fmaxf(s0[r], s1[r]));
    return fmaxf(mx, __shfl_xor(mx, 32));
}
__device__ __forceinline__ void softmax_pv(ASt& st, f32x16& s0, f32x16& s1, const LAS unsigned char* VT, int r32, int hi) {
    const float mnew = fmaxf(st.m, rowmax32(s0, s1));
    const float muse = (mnew == -INFINITY) ? 0.f : mnew;
    const float alpha = fexp2(st.m - muse);
    st.m = mnew;
    float ls = 0.f;
#pragma unroll
    for (int r = 0; r < 16; ++r) { s0[r] = fexp2(s0[r] - muse); s1[r] = fexp2(s1[r] - muse); ls += s0[r] + s1[r]; }
    st.l = st.l * alpha + ls;
#pragma unroll
    for (int r = 0; r < 16; ++r) { st.o0[r] *= alpha; st.o1[r] *= alpha; }
    pv_tile(st.o0, st.o1, s0, s1, VT, r32, hi);
}
__device__ __forceinline__ void softmax_stats(float& m, float& l, const f32x16& s0, const f32x16& s1) {
    const float mnew = fmaxf(m, rowmax32(s0, s1));
    const float muse = (mnew == -INFINITY) ? 0.f : mnew;
    const float alpha = fexp2(m - muse);
    m = mnew;
    float ls = 0.f;
#pragma unroll
    for (int r = 0; r < 16; ++r) ls += fexp2(s0[r] - muse) + fexp2(s1[r] - muse);
    l = l * alpha + ls;
}
__device__ __forceinline__ void ast_init(ASt& st) {
#pragma unroll
    for (int r = 0; r < 16; ++r) { st.o0[r] = 0.f; st.o1[r] = 0.f; }
    st.m = -INFINITY; st.l = 0.f;
}
__device__ __forceinline__ float ast_inv(const ASt& st) { const float lt = st.l + __shfl_xor(st.l, 32); return lt > 0.f ? 1.f / lt : 0.f; }
constexpr int NWAVES = 8, NTHR = 512;
constexpr int T = 8192, M = 16384, D = 1024, DFF = 2816;
constexpr size_t MiB = (size_t)1 << 20;
constexpr size_t WS_CTL = 0, CTL_BYTES = 65536, WS_ROPE = 1 * MiB, WS_CMPB = 2 * MiB;
constexpr size_t WS_WGU = 4 * MiB, WS_WDN = 92 * MiB, WS_WOUT = 136 * MiB, WS_WMLAIN = 144 * MiB, WS_WUQ = 147 * MiB, WS_WUKV = 149 * MiB, WS_WNSAIN = 150 * MiB,
                 WS_WKV = 155 * MiB, WS_WC1 = 157 * MiB, WS_WC2 = 159 * MiB, WS_WMEM = 160 * MiB, WS_MEMB = 164 * MiB, WS_MEMKV = 165 * MiB, WS_NSAKV = 167 * MiB,
                 WS_HID = 192 * MiB, WS_KCVC = 194 * MiB, WS_SEL = 195 * MiB, WS_GATES = 196 * MiB, WS_Z = 200 * MiB, WS_XB = 264 * MiB, WS_ACT = 296 * MiB,
                 WS_C768 = 296 * MiB, WS_Q = 344 * MiB, WS_K = 384 * MiB, WS_V = 408 * MiB, WS_KR = 432 * MiB, WS_CQN = 433 * MiB, WS_CKVN = 441 * MiB,
                 WS_QMEM = 445 * MiB, WS_MIX = 453 * MiB, WS_OACC = 485 * MiB, WS_END = 533 * MiB;
constexpr int LDS_BYTES = 147456, RING_BYTES = 131072, MISC_OFF = RING_BYTES, IMP_OFF = 49152, IMP_STRIDE = 132;
constexpr float DN_ALPHA = 1.681792830507429f;
__constant__ float ROPE_FREQ[16] = {1.000000000e+00f, 5.623413324e-01f, 3.162277639e-01f, 1.778279394e-01f, 1.000000015e-01f, 5.623413250e-02f, 3.162277490e-02f, 1.778279431e-02f,
                                    9.999999776e-03f, 5.623413250e-03f, 3.162277630e-03f, 1.778279431e-03f, 1.000000047e-03f, 5.623413017e-04f, 3.162277571e-04f, 1.778279402e-04f};
__constant__ float SLOPES[12] = {0.5f, 0.25f, 0.125f, 0.0625f, 0.03125f, 0.015625f, 0.0078125f, 0.00390625f, 0.7071067690849304f, 0.3535533845424652f, 0.1767766922712326f, 0.0883883461356163f};

struct Args { const float* in[19]; float* out; unsigned char* ws; };
struct Ctx {
    LAS unsigned char* lds; unsigned char* ws; const float* const* in; float* out;
    int tid, lane, wave, r32, hi, bid;
};
__device__ __forceinline__ float wave_sum(float v) {
#pragma unroll
    for (int o = 1; o < 64; o <<= 1) v += __shfl_xor(v, o);
    return v;
}
__device__ __forceinline__ unsigned f2bf(float f) { const _Float16 h = (_Float16)f; return (unsigned)__builtin_bit_cast(unsigned short, h); }
__device__ __forceinline__ unsigned pk2(float lo, float hi) { return f2bf(lo) | (f2bf(hi) << 16); }

enum { CM_ID = 0, CM_GU = 1, CM_MLAIN = 2, CM_UQ = 3, CM_NSAIN = 4, CM_C2 = 5 };
__device__ __forceinline__ int colmap(int id, int n) {
    switch (id) {
        case CM_GU: { const int pn = n >> 8, w = n & 255; return w < 128 ? pn * 128 + w : DFF + pn * 128 + (w - 128); }
        case CM_MLAIN: return n < 672 ? n : -1;
        case CM_UQ: { if (n < 768) return (n >> 6) * 96 + (n & 63); const int w = n - 768, tile = w >> 8, half = (w >> 7) & 1, lc = w & 127, h = tile * 8 + (lc >> 4), j = lc & 15; return h < 12 ? h * 96 + 64 + half * 16 + j : -1; }
        case CM_NSAIN: { if (n < 768) return n; if (n < 1024) return 804 + (n - 768); const int gi = n - 1024; return gi < 36 ? 768 + gi : -1; }
        case CM_C2: return n < 64 ? n : -1;
        default: return n;
    }
}
__device__ __forceinline__ void tr_item(const float* W, int K, int N, bf16_t* WT, int id, LAS float* scr, int item, int nblk, int lane) {
    const int kb = item / nblk, nb = item - kb * nblk, k0 = 64 * kb, n0 = 32 * nb;
    const int sc = colmap(id, n0 + (lane & 31));
#pragma unroll 8
    for (int i = 0; i < 32; ++i) { const int kk = 2 * i + (lane >> 5); scr[kk * 33 + (lane & 31)] = sc >= 0 ? W[(size_t)(k0 + kk) * N + sc] : 0.f; }
    asm volatile("s_waitcnt lgkmcnt(0)" ::: "memory");
    const int c = lane & 7;
#pragma unroll
    for (int j = 0; j < 4; ++j) { const int n = (lane >> 3) + 8 * j; const LAS float* s = scr + (8 * c) * 33 + n;
        u32x4 o; o.x = pk2(s[0 * 33], s[1 * 33]); o.y = pk2(s[2 * 33], s[3 * 33]); o.z = pk2(s[4 * 33], s[5 * 33]); o.w = pk2(s[6 * 33], s[7 * 33]);
        *(u32x4*)(WT + (size_t)(n0 + n) * K + k0 + 8 * c) = o; }
    asm volatile("s_waitcnt lgkmcnt(0)" ::: "memory");
}
__device__ __forceinline__ void prologue(const Ctx& C) {
    LAS float* scr = (LAS float*)(C.lds + C.wave * 16384);
    const int gw = C.bid * NWAVES + C.wave, NGW = gridDim.x * NWAVES;
    unsigned char* ws = C.ws;
#define FAM(SRC, SSTR, KK, NS, ND, DST, DSTR, MAPID, CNT) { const int ipm = ((KK) / 64) * ((ND) / 32); if (r < ipm * (CNT)) { const int mi = r / ipm; \
        tr_item((SRC) + (size_t)mi * (SSTR), (KK), (NS), (bf16_t*)(DST) + (size_t)mi * (DSTR), (MAPID), scr, r - mi * ipm, (ND) / 32, C.lane); continue; } r -= ipm * (CNT); }
    constexpr int NITEMS = 8 * 16 * 176 + 8 * 44 * 32 + 4 * 16 * 32 + 2 * 16 * 24 + 2 * 4 * 40 + 2 * 2 * 48 + 2 * 16 * 40 + 16 * 24 + 2 * 32 * 8 + 2 * 4 * 8 + 4 * 16 * 16;
    for (int it = gw; it < NITEMS; it += NGW) {
        int r = it;
        FAM(C.in[4], (size_t)D * 2 * DFF, D, 2 * DFF, 2 * DFF, ws + WS_WGU, (size_t)2 * DFF * D, CM_GU, 8)
        FAM(C.in[5], (size_t)DFF * D, DFF, D, D, ws + WS_WDN, (size_t)D * DFF, CM_ID, 8)
        FAM(C.in[7], (size_t)D * D, D, D, D, ws + WS_WOUT, (size_t)D * D, CM_ID, 4)
        FAM(C.in[8], (size_t)D * 672, D, 672, 768, ws + WS_WMLAIN, (size_t)768 * D, CM_MLAIN, 2)
        FAM(C.in[11], (size_t)256 * 1152, 256, 1152, 1280, ws + WS_WUQ, (size_t)1280 * 256, CM_UQ, 2)
        FAM(C.in[12], (size_t)128 * 1536, 128, 1536, 1536, ws + WS_WUKV, (size_t)1536 * 128, CM_ID, 2)
        FAM(C.in[13], (size_t)D * 1060, D, 1060, 1280, ws + WS_WNSAIN, (size_t)1280 * D, CM_NSAIN, 2)
        FAM(C.in[14], (size_t)0, D, 768, 768, ws + WS_WKV, (size_t)0, CM_ID, 1)
        FAM(C.in[16], (size_t)2048 * 256, 2048, 256, 256, ws + WS_WC1, (size_t)256 * 2048, CM_ID, 2)
        FAM(C.in[18], (size_t)256 * 64, 256, 64, 256, ws + WS_WC2, (size_t)256 * 256, CM_C2, 2)
        FAM(C.in[6], (size_t)D * 512, D, 512, 512, ws + WS_WMEM, (size_t)512 * D, CM_ID, 4)
    }
#undef FAM
    { float* rt = (float*)(ws + WS_ROPE);
      for (int i = C.bid * NTHR + C.tid; i < T * 16; i += gridDim.x * NTHR) {
          const float ang = (float)(i >> 4) * ROPE_FREQ[i & 15];
          const double a = (double)ang, k = __builtin_rint(a * 0.15915494309189535), rr = a - k * 6.283185307179586, r2 = rr * rr;
          double sn = -1.0 / 51090942171709440000.0;
          sn = sn * r2 + 1.0 / 121645100408832000.0; sn = sn * r2 - 1.0 / 355687428096000.0; sn = sn * r2 + 1.0 / 1307674368000.0; sn = sn * r2 - 1.0 / 6227020800.0; sn = sn * r2 + 1.0 / 39916800.0;
          sn = sn * r2 - 1.0 / 362880.0; sn = sn * r2 + 1.0 / 5040.0; sn = sn * r2 - 1.0 / 120.0; sn = sn * r2 + 1.0 / 6.0; sn = sn * r2 * -1.0 + 1.0; sn = sn * rr;
          double cs = 1.0 / 2432902008176640000.0;
          cs = cs * r2 - 1.0 / 6402373705728000.0; cs = cs * r2 + 1.0 / 20922789888000.0; cs = cs * r2 - 1.0 / 87178291200.0; cs = cs * r2 + 1.0 / 479001600.0; cs = cs * r2 - 1.0 / 3628800.0;
          cs = cs * r2 + 1.0 / 40320.0; cs = cs * r2 - 1.0 / 720.0; cs = cs * r2 + 1.0 / 24.0; cs = cs * r2 - 0.5; cs = cs * r2 + 1.0;
          rt[2 * i] = (float)cs; rt[2 * i + 1] = (float)sn; } }
    if (C.bid < 2) {
        const int j = C.bid; const float* w1 = C.in[16] + (size_t)j * 2048 * 256; const float* pos = C.in[15] + (size_t)j * 2048;
        f32x4 acc = {0.f, 0.f, 0.f, 0.f};
        for (int k = C.wave * 256; k < C.wave * 256 + 256; ++k) { const float p = pos[k]; const f32x4 w = *(const f32x4*)(w1 + (size_t)k * 256 + C.lane * 4); acc += w * p; }
        LAS float* red = (LAS float*)(C.lds + 8 * 16384);
        __syncthreads();
        *(LAS f32x4*)(red + C.wave * 256 + C.lane * 4) = acc;
        __syncthreads();
        if (C.tid < 256) { float s = C.in[17][j * 256 + C.tid];
#pragma unroll
            for (int w = 0; w < 8; ++w) s += red[w * 256 + C.tid];
            ((float*)(ws + WS_CMPB))[j * 256 + C.tid] = s; }
    }
    { const f32x4* x4 = (const f32x4*)C.in[0]; u32x2* xb = (u32x2*)(ws + WS_XB);
      for (size_t i = (size_t)C.bid * NTHR + C.tid; i < (size_t)M * D / 4; i += (size_t)gridDim.x * NTHR) { const f32x4 v = x4[i]; u32x2 o; o.x = pk2(v[0], v[1]); o.y = pk2(v[2], v[3]); xb[i] = o; }
      const f32x4* m4 = (const f32x4*)C.in[1]; u32x2* mb = (u32x2*)(ws + WS_MEMB);
      for (size_t i = (size_t)C.bid * NTHR + C.tid; i < (size_t)512 * D / 4; i += (size_t)gridDim.x * NTHR) { const f32x4 v = m4[i]; u32x2 o; o.x = pk2(v[0], v[1]); o.y = pk2(v[2], v[3]); mb[i] = o; } }
}
__device__ __forceinline__ void ln_phase(const Ctx& C, const float* Z, const float* g, const float* b, float* X, bf16_t* XB) {
    const int gw = C.bid * NWAVES + C.wave, NGW = gridDim.x * NWAVES;
    f32x4 gv[4], bv[4];
#pragma unroll
    for (int j = 0; j < 4; ++j) { gv[j] = *(const f32x4*)(g + C.lane * 4 + 256 * j); bv[j] = *(const f32x4*)(b + C.lane * 4 + 256 * j); }
    for (int row = gw; row < M; row += NGW) {
        const f32x4* zr = (const f32x4*)(Z + (size_t)row * D) + C.lane;
        f32x4 v[4]; float s = 0.f;
#pragma unroll
        for (int j = 0; j < 4; ++j) { v[j] = zr[64 * j]; s += (v[j][0] + v[j][1]) + (v[j][2] + v[j][3]); }
        const float mean = wave_sum(s) * (1.f / D); float s2 = 0.f;
#pragma unroll
        for (int j = 0; j < 4; ++j) { v[j] = v[j] - mean; s2 += (v[j][0] * v[j][0] + v[j][1] * v[j][1]) + (v[j][2] * v[j][2] + v[j][3] * v[j][3]); }
        const float rstd = 1.f / sqrtf(wave_sum(s2) * (1.f / D) + 1e-5f);
        f32x4* xo = (f32x4*)(X + (size_t)row * D) + C.lane; u32x2* bo = (u32x2*)(XB + (size_t)row * D) + C.lane;
#pragma unroll
        for (int j = 0; j < 4; ++j) { const f32x4 y = v[j] * rstd * gv[j] + bv[j]; xo[64 * j] = y; u32x2 o; o.x = pk2(y[0], y[1]); o.y = pk2(y[2], y[3]); bo[64 * j] = o; }
    }
}
__device__ __forceinline__ void prep_phase(const Ctx& C, const float* gq, const float* gkv) {
    const int gw = C.bid * NWAVES + C.wave, NGW = gridDim.x * NWAVES;
    unsigned char* ws = C.ws; const float* C768 = (const float*)(ws + WS_C768); const float* rope = (const float*)(ws + WS_ROPE);
    bf16_t* CQN = (bf16_t*)(ws + WS_CQN); bf16_t* CKVN = (bf16_t*)(ws + WS_CKVN); bf16_t* KR = (bf16_t*)(ws + WS_KR); bf16_t* QMEM = (bf16_t*)(ws + WS_QMEM);
    const f32x4 g1 = *(const f32x4*)(gq + C.lane * 4); const f32x4 g2 = *(const f32x4*)(gkv + (C.lane & 31) * 4);
    for (int row = gw; row < M; row += NGW) {
        const float* cr = C768 + (size_t)row * 768;
        const f32x4 cq = *(const f32x4*)(cr + C.lane * 4);
        f32x4 ckv = {0.f, 0.f, 0.f, 0.f}; if (C.lane < 32) ckv = *(const f32x4*)(cr + 256 + C.lane * 4);
        const f32x4 qm = *(const f32x4*)(cr + 416 + C.lane * 4);
        const float rq = 1.f / sqrtf(wave_sum((cq[0] * cq[0] + cq[1] * cq[1]) + (cq[2] * cq[2] + cq[3] * cq[3])) * (1.f / 256.f) + 1e-6f);
        const float rkv = 1.f / sqrtf(wave_sum((ckv[0] * ckv[0] + ckv[1] * ckv[1]) + (ckv[2] * ckv[2] + ckv[3] * ckv[3])) * (1.f / 128.f) + 1e-6f);
        { const f32x4 y = cq * rq * g1; u32x2 o; o.x = pk2(y[0], y[1]); o.y = pk2(y[2], y[3]); *((u32x2*)(CQN + (size_t)row * 256) + C.lane) = o; }
        if (C.lane < 32) { const f32x4 y = ckv * rkv * g2; u32x2 o; o.x = pk2(y[0], y[1]); o.y = pk2(y[2], y[3]); *((u32x2*)(CKVN + (size_t)row * 128) + C.lane) = o; }
        { const f32x4 y = qm * (0.125f * LOG2E); u32x2 o; o.x = pk2(y[0], y[1]); o.y = pk2(y[2], y[3]); *((u32x2*)(QMEM + (size_t)row * 256) + C.lane) = o; }
        if (C.lane < 16) { const float x1 = cr[384 + C.lane], x2 = cr[400 + C.lane]; const int pos = row & (T - 1); const float co = rope[(pos * 16 + C.lane) * 2], si = rope[(pos * 16 + C.lane) * 2 + 1];
            KR[(size_t)row * 32 + C.lane] = (bf16_t)f2bf(x1 * co - x2 * si); KR[(size_t)row * 32 + 16 + C.lane] = (bf16_t)f2bf(x2 * co + x1 * si); }
    }
}
#define STAGE_BUF(b) (C.lds + (b) * ABUF)
#define LDS_ADD(p, v) (void)__hip_atomic_fetch_add((p), (v), __ATOMIC_RELAXED, __HIP_MEMORY_SCOPE_WORKGROUP)
#define LDS_OR(p, v) (void)__hip_atomic_fetch_or((p), (v), __ATOMIC_RELAXED, __HIP_MEMORY_SCOPE_WORKGROUP)
__device__ __forceinline__ void store_o_bf16(const ASt& st, float inv, bf16_t* orow  , int hi) {
#pragma unroll
    for (int g4 = 0; g4 < 4; ++g4) {
        u32x2 w0, w1;
        w0.x = cvt_pk_bf16(st.o0[4 * g4] * inv, st.o0[4 * g4 + 1] * inv); w0.y = cvt_pk_bf16(st.o0[4 * g4 + 2] * inv, st.o0[4 * g4 + 3] * inv);
        w1.x = cvt_pk_bf16(st.o1[4 * g4] * inv, st.o1[4 * g4 + 1] * inv); w1.y = cvt_pk_bf16(st.o1[4 * g4 + 2] * inv, st.o1[4 * g4 + 3] * inv);
        *(u32x2*)(orow + 8 * g4 + 4 * hi) = w0; *(u32x2*)(orow + 32 + 8 * g4 + 4 * hi) = w1;
    }
}
template <bool MEM> __device__ __forceinline__ void mla_unit(const Ctx& C, int layer, int b, int h, int qb) {
    constexpr int DQK = MEM ? 64 : 96;
    unsigned char* ws = C.ws;
    const int t = qb * 256 + C.wave * 32 + C.r32; const size_t row = (size_t)b * T + t;
    bf16x8 qr[DQK / 16];
    const bf16_t *Kp, *Vp, *KRp = nullptr; int pitch;
    if (MEM) {
        const bf16_t* qp = (const bf16_t*)(ws + WS_QMEM) + row * 256 + h * 64 + C.hi * 8;
#pragma unroll
        for (int d0 = 0; d0 < DQK / 16; ++d0) qr[d0] = *(const bf16x8*)(qp + d0 * 16);
        const bf16_t* mk = (const bf16_t*)(ws + WS_MEMKV);
        Kp = mk + ((((size_t)layer * 2 + 0) * 2 + b) * 4 + h) * 256 * 64; Vp = mk + ((((size_t)layer * 2 + 1) * 2 + b) * 4 + h) * 256 * 64; pitch = 64;
    } else {
        const bf16_t* qp = (const bf16_t*)(ws + WS_Q) + row * 1152 + h * 96 + C.hi * 8;
#pragma unroll
        for (int d0 = 0; d0 < DQK / 16; ++d0) qr[d0] = *(const bf16x8*)(qp + d0 * 16);
        Kp = (const bf16_t*)(ws + WS_K) + (size_t)b * T * 768 + h * 64; Vp = (const bf16_t*)(ws + WS_V) + (size_t)b * T * 768 + h * 64; KRp = (const bf16_t*)(ws + WS_KR) + (size_t)b * T * 32; pitch = 768;
    }
    const int nt = MEM ? 4 : 4 * qb + 4, wlast = MEM ? 3 : 4 * qb + (C.wave >> 1), tmin = qb * 256 + C.wave * 32;
    ASt st; ast_init(st);
    TReg R;
    tile_load<!MEM>(R, Kp, pitch, KRp, Vp, pitch, C.tid);
    tile_store<DQK>(R, STAGE_BUF(0), C.tid);
    __syncthreads();
    for (int kt = 0; kt < nt; ++kt) {
        if (kt + 1 < nt) tile_load<!MEM>(R, Kp + (size_t)(kt + 1) * 64 * pitch, pitch, KRp + (size_t)(kt + 1) * 64 * 32, Vp + (size_t)(kt + 1) * 64 * pitch, pitch, C.tid);
        if (kt <= wlast) {
            const LAS unsigned char* buf = STAGE_BUF(kt & 1);
            f32x16 s0, s1;
#pragma unroll
            for (int r = 0; r < 16; ++r) { s0[r] = 0.f; s1[r] = 0.f; }
            qk_tile<DQK>(buf, qr, s0, s1, C.r32, C.hi);
            if (!MEM) { if (kt * 64 + 63 > tmin) mask_tile(s0, s1, t - kt * 64 - 4 * C.hi, -1000000); }
            softmax_pv(st, s0, s1, buf + AVOFF, C.r32, C.hi);
        }
        if (kt + 1 < nt) tile_store<DQK>(R, STAGE_BUF((kt + 1) & 1), C.tid);
        __syncthreads();
    }
    const float inv = ast_inv(st) * (MEM ? ABL_MEM : ABL_MLA);
    store_o_bf16(st, inv, (bf16_t*)(ws + WS_MIX) + row * 1024 + (MEM ? 768 : 0) + h * 64, C.hi);
}
__device__ __forceinline__ void mla_attn_phase(const Ctx& C, int layer, unsigned* ctr, bool with_mla) {
    LAS int* su = (LAS int*)(C.lds + MISC_OFF);
    const int nmla = with_mla ? 768 : 0, total = nmla + 256;
    for (;;) {
        __syncthreads();
        if (C.tid == 0) su[0] = (int)atomicAdd(ctr, 1u);
        __syncthreads();
        const int u = su[0];
        if (u >= total) break;
        if (u < nmla) { const int qb = 31 - u / 24, bh = u % 24; mla_unit<false>(C, layer, bh / 12, bh % 12, qb); }
        else { const int v = u - nmla; mla_unit<true>(C, layer, v >> 7, (v >> 5) & 3, v & 31); }
    }
}
__device__ __forceinline__ void nsa1_unit(const Ctx& C, int b, int g, int qb) {
    unsigned char* ws = C.ws;
    const int qsub = C.wave & 3, hh = C.wave >> 2;
    const int tmin = qb * 128 + qsub * 32, t = tmin + C.r32; const size_t row = (size_t)b * T + t;
    LAS unsigned* imp = (LAS unsigned*)(C.lds + IMP_OFF);
    for (int i = C.tid; i < 128 * IMP_STRIDE; i += NTHR) imp[i] = 0u;
    const int nt = ((8 * qb + 6) >> 6) + 1;
    const int nmax_w = 8 * qb + 2 * qsub, wlast = nmax_w >> 6;
    const int nfull = (tmin - 31) >> 4;
    const int nlim = (t - 31) >> 4;
    const bf16_t* Kp = (const bf16_t*)(ws + WS_KCVC) + (size_t)(b * 2 + g) * 512 * 64; const bf16_t* Vp = Kp + (size_t)4 * 512 * 64;
    const float* gates = (const float*)(ws + WS_GATES); float* OACC = (float*)(ws + WS_OACC);
    __syncthreads();
    for (int i3 = 0; i3 < 3; ++i3) {
        const int h = g * 6 + hh * 3 + i3;
        const float sl2 = SLOPES[h] * LOG2E, se = 16.f * sl2;
        bf16x8 qr[4];
        { const bf16_t* qp = (const bf16_t*)(ws + WS_Q) + row * 768 + h * 64 + C.hi * 8;
#pragma unroll
          for (int d0 = 0; d0 < 4; ++d0) qr[d0] = *(const bf16x8*)(qp + d0 * 16); }
        float m = -INFINITY, l = 0.f;
        TReg R;
        tile_load<false>(R, Kp, 64, nullptr, Vp, 64, C.tid); tile_store<64>(R, STAGE_BUF(0), C.tid); __syncthreads();
        for (int kt = 0; kt < nt; ++kt) {
            if (kt + 1 < nt) tile_load<false>(R, Kp + (size_t)(kt + 1) * 4096, 64, nullptr, Vp + (size_t)(kt + 1) * 4096, 64, C.tid);
            if (kt <= wlast) {
                const LAS unsigned char* buf = STAGE_BUF(kt & 1);
                f32x16 s0, s1; const int nb = kt * 64 + 4 * C.hi;
                bias_init(s0, s1, se, sl2 * ((float)(16 * nb - t) + 15.5f));
                qk_tile<64>(buf, qr, s0, s1, C.r32, C.hi);
                if (kt * 64 + 63 > nfull) mask_tile(s0, s1, nlim - nb, -1000000);
                softmax_stats(m, l, s0, s1);
            }
            if (kt + 1 < nt) tile_store<64>(R, STAGE_BUF((kt + 1) & 1), C.tid);
            __syncthreads();
        }
        const float lt = l + __shfl_xor(l, 32); const float inv = lt > 0.f ? 1.f / lt : 0.f; const float muse = (m == -INFINITY) ? 0.f : m;
        f32x16 o0, o1;
#pragma unroll
        for (int r = 0; r < 16; ++r) { o0[r] = 0.f; o1[r] = 0.f; }
        tile_load<false>(R, Kp, 64, nullptr, Vp, 64, C.tid); tile_store<64>(R, STAGE_BUF(0), C.tid); __syncthreads();
        for (int kt = 0; kt < nt; ++kt) {
            if (kt + 1 < nt) tile_load<false>(R, Kp + (size_t)(kt + 1) * 4096, 64, nullptr, Vp + (size_t)(kt + 1) * 4096, 64, C.tid);
            if (kt <= wlast) {
                const LAS unsigned char* buf = STAGE_BUF(kt & 1);
                f32x16 s0, s1; const int nb = kt * 64 + 4 * C.hi;
                bias_init(s0, s1, se, sl2 * ((float)(16 * nb - t) + 15.5f));
                qk_tile<64>(buf, qr, s0, s1, C.r32, C.hi);
                if (kt * 64 + 63 > nfull) mask_tile(s0, s1, nlim - nb, -1000000);
#pragma unroll
                for (int r = 0; r < 16; ++r) { s0[r] = fexp2(s0[r] - muse) * inv; s1[r] = fexp2(s1[r] - muse) * inv; }
                LAS unsigned* ip = imp + (qsub * 32 + C.r32) * IMP_STRIDE + kt * 16 + C.hi;
#pragma unroll
                for (int i4 = 0; i4 < 4; ++i4) {
                    { const float sp = 0.5f * s0[4 * i4 + 3], a = (s0[4 * i4] + s0[4 * i4 + 1]) + (s0[4 * i4 + 2] + sp);
                      LDS_ADD(ip + 2 * i4, (unsigned)(a * 134217728.f + 0.5f)); LDS_ADD(ip + 2 * i4 + 1, (unsigned)(sp * 134217728.f + 0.5f)); }
                    { const float sp = 0.5f * s1[4 * i4 + 3], a = (s1[4 * i4] + s1[4 * i4 + 1]) + (s1[4 * i4 + 2] + sp);
                      LDS_ADD(ip + 8 + 2 * i4, (unsigned)(a * 134217728.f + 0.5f)); LDS_ADD(ip + 8 + 2 * i4 + 1, (unsigned)(sp * 134217728.f + 0.5f)); }
                }
                pv_tile(o0, o1, s0, s1, buf + AVOFF, C.r32, C.hi);
            }
            if (kt + 1 < nt) tile_store<64>(R, STAGE_BUF((kt + 1) & 1), C.tid);
            __syncthreads();
        }
        const float gc = gates[row * 64 + h * 3 + 0] * ABL_CMP;
        float* op = OACC + row * 768 + h * 64 + 4 * C.hi;
#pragma unroll
        for (int g4 = 0; g4 < 4; ++g4) {
            *(f32x4*)(op + 8 * g4) = (f32x4){o0[4 * g4] * gc, o0[4 * g4 + 1] * gc, o0[4 * g4 + 2] * gc, o0[4 * g4 + 3] * gc};
            *(f32x4*)(op + 32 + 8 * g4) = (f32x4){o1[4 * g4] * gc, o1[4 * g4 + 1] * gc, o1[4 * g4 + 2] * gc, o1[4 * g4 + 3] * gc};
        }
    }
    __syncthreads();
    {
        const int ql = C.wave * 16 + (C.lane >> 2), sub = C.lane & 3, tq = qb * 128 + ql, cur = tq >> 6;
        const LAS unsigned* ip = imp + ql * IMP_STRIDE + sub * 32;
        unsigned k[32];
#pragma unroll
        for (int i = 0; i < 32; ++i) { const int j = sub * 32 + i; const unsigned v = ip[i]; const bool valid = j <= cur, forced = (j == 0) | (j == cur) | (j == cur - 1);
            k[i] = valid ? ((forced ? 0x80000000u : 0x40000000u) | (v < 0x3fffffffu ? v : 0x3fffffffu)) : 0u; }
        unsigned myword = 0u;
        for (int round = 0; round < 16; ++round) {
            unsigned best = 0u; int bi = 0;
#pragma unroll
            for (int i = 0; i < 32; ++i) if (k[i] > best) { best = k[i]; bi = i; }
            int gidx = sub * 32 + bi;
#pragma unroll
            for (int off = 1; off < 4; off <<= 1) { const unsigned ob = __shfl_xor(best, off); const int oi = __shfl_xor(gidx, off); if (ob > best || (ob == best && oi < gidx)) { best = ob; gidx = oi; } }
            if (best != 0u && (gidx >> 5) == sub) { const int bit = gidx & 31; myword |= 1u << bit;
#pragma unroll
                for (int i = 0; i < 32; ++i) if (i == bit) k[i] = 0u; }
        }
        ((unsigned*)(ws + WS_SEL))[((size_t)(b * 2 + g) * T + tq) * 4 + sub] = myword;
    }
}
__device__ __forceinline__ void nsa1_phase(const Ctx& C, unsigned* ctr) {
    LAS int* su = (LAS int*)(C.lds + MISC_OFF);
    for (;;) {
        __syncthreads();
        if (C.tid == 0) su[0] = (int)atomicAdd(ctr, 1u);
        __syncthreads();
        const int u = su[0];
        if (u >= 256) break;
        const int qb = 63 - (u >> 2), bg = u & 3;
        nsa1_unit(C, bg >> 1, bg & 1, qb);
    }
}
__device__ __forceinline__ int next_bit(unsigned u0, unsigned u1, unsigned u2, unsigned u3, int from) {
    if (from < 32) { const unsigned m = u0 & (~0u << from); if (m) return __builtin_ctz(m); from = 32; }
    if (from < 64) { const unsigned m = u1 & (~0u << (from - 32)); if (m) return 32 + __builtin_ctz(m); from = 64; }
    if (from < 96) { const unsigned m = u2 & (~0u << (from - 64)); if (m) return 64 + __builtin_ctz(m); from = 96; }
    if (from < 128) { const unsigned m = u3 & (~0u << (from - 96)); if (m) return 96 + __builtin_ctz(m); }
    return 128;
}
__device__ __forceinline__ void nsa2_unit(const Ctx& C, int b, int h, int qb) {
    unsigned char* ws = C.ws;
    const int g = h / 6;
    const int tmin = qb * 256 + C.wave * 32, tmax = tmin + 31, t = tmin + C.r32; const size_t row = (size_t)b * T + t;
    const float sl2 = SLOPES[h] * LOG2E;
    bf16x8 qr[4];
    { const bf16_t* qp = (const bf16_t*)(ws + WS_Q) + row * 768 + h * 64 + C.hi * 8;
#pragma unroll
      for (int d0 = 0; d0 < 4; ++d0) qr[d0] = *(const bf16x8*)(qp + d0 * 16); }
    const u32x4 selw = *(const u32x4*)((const unsigned*)(ws + WS_SEL) + ((size_t)(b * 2 + g) * T + t) * 4);
    const bf16_t* KV = (const bf16_t*)(ws + WS_NSAKV);
#define KVP(br, kvi) (KV + ((((size_t)(br) * 2 + (kvi)) * 2 + b) * 2 + g) * T * 64)
    const float* gates = (const float*)(ws + WS_GATES);
    f32x16 a0, a1;
    TReg R;
    {
        const bf16_t* Kp = KVP(2, 0); const bf16_t* Vp = KVP(2, 1);
        const int t0 = (4 * qb - 8) > 0 ? (4 * qb - 8) : 0, t1 = 4 * qb + 3;
        const int wlo = (tmin - 511) > 0 ? ((tmin - 511) >> 6) : 0, whi = tmax >> 6;
        ASt st; ast_init(st);
        tile_load<false>(R, Kp + (size_t)t0 * 4096, 64, nullptr, Vp + (size_t)t0 * 4096, 64, C.tid); tile_store<64>(R, STAGE_BUF(0), C.tid); __syncthreads();
        int pb = 0;
        for (int kt = t0; kt <= t1; ++kt) {
            if (kt < t1) tile_load<false>(R, Kp + (size_t)(kt + 1) * 4096, 64, nullptr, Vp + (size_t)(kt + 1) * 4096, 64, C.tid);
            if (kt >= wlo && kt <= whi) {
                const LAS unsigned char* buf = STAGE_BUF(pb);
                f32x16 s0, s1; const int kb = kt * 64 + 4 * C.hi;
                bias_init(s0, s1, sl2, sl2 * (float)(kb - t));
                qk_tile<64>(buf, qr, s0, s1, C.r32, C.hi);
                if (!(kt * 64 + 63 <= tmin && tmax - kt * 64 <= 511)) mask_tile(s0, s1, t - kb, t - kb - 512);
                softmax_pv(st, s0, s1, buf + AVOFF, C.r32, C.hi);
            }
            if (kt < t1) tile_store<64>(R, STAGE_BUF(pb ^ 1), C.tid);
            pb ^= 1;
            __syncthreads();
        }
        const float sc = ast_inv(st) * gates[row * 64 + h * 3 + 2] * ABL_WIN;
#pragma unroll
        for (int r = 0; r < 16; ++r) { a0[r] = st.o0[r] * sc; a1[r] = st.o1[r] * sc; }
    }
    ASt st; ast_init(st);
    {
        const bf16_t* Kp = KVP(1, 0); const bf16_t* Vp = KVP(1, 1);
        LAS unsigned* un = (LAS unsigned*)(C.lds + MISC_OFF + 64);
        if (C.tid < 4) un[C.tid] = 0u;
        __syncthreads();
        { unsigned w0 = selw.x, w1 = selw.y, w2 = selw.z, w3 = selw.w;
#pragma unroll
          for (int o = 1; o < 64; o <<= 1) { w0 |= __shfl_xor(w0, o); w1 |= __shfl_xor(w1, o); w2 |= __shfl_xor(w2, o); w3 |= __shfl_xor(w3, o); }
          if (C.lane == 0) { LDS_OR(un + 0, w0); LDS_OR(un + 1, w1); LDS_OR(un + 2, w2); LDS_OR(un + 3, w3); } }
        __syncthreads();
        const unsigned u0 = un[0], u1 = un[1], u2 = un[2], u3 = un[3];
        int j = next_bit(u0, u1, u2, u3, 0);
        int pb = 0;
        if (j < 128) { tile_load<false>(R, Kp + (size_t)j * 4096, 64, nullptr, Vp + (size_t)j * 4096, 64, C.tid); tile_store<64>(R, STAGE_BUF(0), C.tid); }
        __syncthreads();
        while (j < 128) {
            const int jn = next_bit(u0, u1, u2, u3, j + 1);
            if (jn < 128) tile_load<false>(R, Kp + (size_t)jn * 4096, 64, nullptr, Vp + (size_t)jn * 4096, 64, C.tid);
            const unsigned wsel = j < 32 ? selw.x : (j < 64 ? selw.y : (j < 96 ? selw.z : selw.w));
            const bool mine = (wsel >> (j & 31)) & 1u;
            if (__ballot(mine) != 0ull) {
                const LAS unsigned char* buf = STAGE_BUF(pb);
                f32x16 s0, s1; const int kb = j * 64 + 4 * C.hi;
                bias_init(s0, s1, sl2, sl2 * (float)(kb - t));
                qk_tile<64>(buf, qr, s0, s1, C.r32, C.hi);
                mask_tile(s0, s1, mine ? t - kb : -1000, -1000000);
                softmax_pv(st, s0, s1, buf + AVOFF, C.r32, C.hi);
            }
            if (jn < 128) tile_store<64>(R, STAGE_BUF(pb ^ 1), C.tid);
            pb ^= 1; j = jn;
            __syncthreads();
        }
    }
    {
        const float sc = ast_inv(st) * gates[row * 64 + h * 3 + 1] * ABL_SEL;
        const float* op = (const float*)(ws + WS_OACC) + row * 768 + h * 64 + 4 * C.hi;
        bf16_t* mp = (bf16_t*)(ws + WS_MIX) + row * 1024 + h * 64 + 4 * C.hi;
#pragma unroll
        for (int g4 = 0; g4 < 4; ++g4) {
            const f32x4 c0 = *(const f32x4*)(op + 8 * g4), c1 = *(const f32x4*)(op + 32 + 8 * g4);
            u32x2 w0, w1;
            w0.x = cvt_pk_bf16(c0[0] + a0[4 * g4] + st.o0[4 * g4] * sc, c0[1] + a0[4 * g4 + 1] + st.o0[4 * g4 + 1] * sc);
            w0.y = cvt_pk_bf16(c0[2] + a0[4 * g4 + 2] + st.o0[4 * g4 + 2] * sc, c0[3] + a0[4 * g4 + 3] + st.o0[4 * g4 + 3] * sc);
            w1.x = cvt_pk_bf16(c1[0] + a1[4 * g4] + st.o1[4 * g4] * sc, c1[1] + a1[4 * g4 + 1] + st.o1[4 * g4 + 1] * sc);
            w1.y = cvt_pk_bf16(c1[2] + a1[4 * g4 + 2] + st.o1[4 * g4 + 2] * sc, c1[3] + a1[4 * g4 + 3] + st.o1[4 * g4 + 3] * sc);
            *(u32x2*)(mp + 8 * g4) = w0; *(u32x2*)(mp + 32 + 8 * g4) = w1;
        }
    }
#undef KVP
}
__device__ __forceinline__ void nsa2_phase(const Ctx& C, int layer, unsigned* ctr) {
    LAS int* su = (LAS int*)(C.lds + MISC_OFF);
    const int total = 768 + 256;
    for (;;) {
        __syncthreads();
        if (C.tid == 0) su[0] = (int)atomicAdd(ctr, 1u);
        __syncthreads();
        const int u = su[0];
        if (u >= total) break;
        if (u < 768) { const int qb = 31 - u / 24, bh = u % 24; nsa2_unit(C, bh / 12, bh % 12, qb); }
        else { const int v = u - 768; mla_unit<true>(C, layer, v >> 7, (v >> 5) & 3, v & 31); }
    }
}
struct GJob { const bf16_t* A; const bf16_t* Bt; int M, N, K, lda; pg8::Epi E; };
__device__ __forceinline__ GJob mkjob(const void* A, const void* Bt, int M_, int N_, int K_, int lda, int mode, void* o0, void* o1, float* of, const float* fin, float s0, float s1) {
    GJob j; j.A = (const bf16_t*)A; j.Bt = (const bf16_t*)Bt; j.M = M_; j.N = N_; j.K = K_; j.lda = lda;
    j.E.mode = mode; j.E.o0 = (bf16_t*)o0; j.E.o1 = (bf16_t*)o1; j.E.of = of; j.E.fin = fin; j.E.s0 = s0; j.E.s1 = s1; return j;
}
enum { K_NONE = 0, K_GEMM = 1, K_LN = 2, K_PREP = 3, K_ATT = 4, K_NSA1 = 5, K_NSA2 = 6 };

__global__ void __launch_bounds__(NTHR, 2) yoco_fwd(Args args) {
    extern __shared__ __attribute__((aligned(16))) unsigned char lds_raw[];
    cg::grid_group grid = cg::this_grid();
    float* X = args.out;
#define MAKE_CTX() unsigned char* ws = args.ws; asm volatile("" : "+s"(ws)); Ctx C; C.lds = (LAS unsigned char*)lds_raw; C.ws = ws; C.in = args.in; C.out = args.out; \
    { int t_ = threadIdx.x; asm volatile("" : "+v"(t_)); C.tid = t_; C.lane = t_ & 63; C.wave = __builtin_amdgcn_readfirstlane(t_ >> 6); C.r32 = t_ & 31; C.hi = (t_ >> 5) & 1; int b_ = blockIdx.x; asm volatile("" : "+s"(b_)); C.bid = b_; } \
    unsigned* ctl = (unsigned*)(ws + WS_CTL); float* Z = (float*)(ws + WS_Z); bf16_t* XB = (bf16_t*)(ws + WS_XB); (void)ctl; (void)Z; (void)XB;
    { MAKE_CTX()
    prologue(C); }
    grid.sync();

    for (int L = 0; L < 4; ++L) {
        const bool mla = L < 2;
        const int nsteps = mla ? (L == 1 ? 15 : 12) : 11;
        for (int s = 0; s < nsteps; ++s) {
            MAKE_CTX()
            int kind = K_NONE, nj = 0, lnidx = 0;
            GJob j0, j1; j0 = mkjob(nullptr, nullptr, 0, 0, 0, 0, 0, nullptr, nullptr, nullptr, nullptr, 0.f, 0.f); j1 = j0;
            const int ffn_lo = mla ? 9 : 8;
            const bool inffn1 = s < 3, inffn2 = (s >= ffn_lo && s < ffn_lo + 3);
            if (inffn1 || inffn2) {
                const int f = inffn2 ? 1 : 0, fs = inffn2 ? s - ffn_lo : s;
                const float* xin = (L == 0 && f == 0) ? args.in[0] : X;
                if (fs == 0) { kind = K_GEMM; nj = 1; j0 = mkjob(XB, (bf16_t*)(ws + WS_WGU) + (size_t)(L * 2 + f) * 2 * DFF * D, M, 2 * DFF, D, D, pg8::EP_SWIGLU, ws + WS_ACT, nullptr, nullptr, nullptr, 0.f, 0.f);
                    if (L == 0 && f == 0) { nj = 2; j1 = mkjob(ws + WS_MEMB, ws + WS_WMEM, 512, 2048, D, D, pg8::EP_MEMKV, ws + WS_MEMKV, nullptr, nullptr, nullptr, 0.f, 0.f); } }
                else if (fs == 1) { kind = K_GEMM; nj = 1; j0 = mkjob(ws + WS_ACT, (bf16_t*)(ws + WS_WDN) + (size_t)(L * 2 + f) * D * DFF, M, D, DFF, DFF, pg8::EP_RESID, nullptr, nullptr, Z, xin, DN_ALPHA, 0.5f); }
                else { kind = K_LN; lnidx = f == 0 ? 0 : 2; }
            } else if (mla && s >= 12) {
                if (s == 12) { kind = K_GEMM; nj = 1; j0 = mkjob(XB, ws + WS_WKV, M, 768, D, D, pg8::EP_KV, ws + WS_NSAKV, nullptr, nullptr, nullptr, 0.f, 0.f); }
                else if (s == 13) { kind = K_GEMM; nj = 2;
                    j0 = mkjob(ws + WS_NSAKV, ws + WS_WC1, 2048, 256, 2048, 1024, pg8::EP_C1, ws + WS_HID, nullptr, nullptr, (const float*)(ws + WS_CMPB), 0.f, 0.f);
                    j1 = mkjob((bf16_t*)(ws + WS_NSAKV) + (size_t)4 * T * 64, (bf16_t*)(ws + WS_WC1) + (size_t)256 * 2048, 2048, 256, 2048, 1024, pg8::EP_C1, (bf16_t*)(ws + WS_HID) + (size_t)2048 * 256, nullptr, nullptr, (const float*)(ws + WS_CMPB) + 256, 0.f, 0.f); }
                else { kind = K_GEMM; nj = 2;
                    j0 = mkjob(ws + WS_HID, ws + WS_WC2, 2048, 256, 256, 256, pg8::EP_C2, ws + WS_KCVC, nullptr, nullptr, nullptr, 0.f, 0.f);
                    j1 = mkjob((bf16_t*)(ws + WS_HID) + (size_t)2048 * 256, (bf16_t*)(ws + WS_WC2) + (size_t)256 * 256, 2048, 256, 256, 256, pg8::EP_C2, (bf16_t*)(ws + WS_KCVC) + (size_t)4 * 512 * 64, nullptr, nullptr, nullptr, 0.f, 0.f); }
            } else if (mla) {
                const int ms = s - 3;
                if (ms == 0) { kind = K_GEMM; nj = 1; j0 = mkjob(XB, (bf16_t*)(ws + WS_WMLAIN) + (size_t)L * 768 * D, M, 768, D, D, pg8::EP_F32, nullptr, nullptr, (float*)(ws + WS_C768), nullptr, 0.f, 0.f); }
                else if (ms == 1) kind = K_PREP;
                else if (ms == 2) { kind = K_GEMM; nj = 2;
                    j0 = mkjob(ws + WS_CQN, (bf16_t*)(ws + WS_WUQ) + (size_t)L * 1280 * 256, M, 1280, 256, 256, pg8::EP_UQ, ws + WS_Q, nullptr, nullptr, (const float*)(ws + WS_ROPE), 0.10206207261596577f * LOG2E, 0.f);
                    j1 = mkjob(ws + WS_CKVN, (bf16_t*)(ws + WS_WUKV) + (size_t)L * 1536 * 128, M, 1536, 128, 128, pg8::EP_UKV, ws + WS_K, ws + WS_V, nullptr, nullptr, 0.f, 0.f); }
                else if (ms == 3) kind = K_ATT;
                else if (ms == 4) { kind = K_GEMM; nj = 1; j0 = mkjob(ws + WS_MIX, (bf16_t*)(ws + WS_WOUT) + (size_t)L * D * D, M, D, D, D, pg8::EP_RESID, nullptr, nullptr, Z, X, DN_ALPHA, 1.0f); }
                else { kind = K_LN; lnidx = 1; }
            } else {
                const int ms = s - 3;
                if (ms == 0) { kind = K_GEMM; nj = 1; j0 = mkjob(XB, (bf16_t*)(ws + WS_WNSAIN) + (size_t)(L - 2) * 1280 * D, M, 1280, D, D, pg8::EP_NSAIN, ws + WS_Q, ws + WS_QMEM, (float*)(ws + WS_GATES), nullptr, 0.125f * LOG2E, 0.f); }
                else if (ms == 1) kind = K_NSA1;
                else if (ms == 2) kind = K_NSA2;
                else if (ms == 3) { kind = K_GEMM; nj = 1; j0 = mkjob(ws + WS_MIX, (bf16_t*)(ws + WS_WOUT) + (size_t)L * D * D, M, D, D, D, pg8::EP_RESID, nullptr, nullptr, Z, X, DN_ALPHA, 1.0f); }
                else { kind = K_LN; lnidx = 1; }
            }
            if (kind == K_GEMM) {
                for (int q = 0; q < nj; ++q) {
                    const GJob& J = q ? j1 : j0;
                    pg8::Gemm g{J.A, J.Bt, J.M, J.N, J.K, J.lda}; pg8::StaticOrder S; S.init(J.M, J.N, (int)gridDim.x, C.bid);
                    pg8::gemm_phase<pg8::Epi, pg8::StaticOrder, true, true>((PG8_LAS unsigned char*)C.lds, g, S, J.E);
                }
            } else if (kind == K_LN) {
                ln_phase(C, Z, args.in[2] + (size_t)(L * 3 + lnidx) * D, args.in[3] + (size_t)(L * 3 + lnidx) * D, X, XB);
            } else if (kind == K_PREP) {
                prep_phase(C, args.in[9] + (size_t)L * 256, args.in[10] + (size_t)L * 128);
            } else if (kind == K_ATT) {
                mla_attn_phase(C, L, ctl + 64 * (1 + L), true);
            } else if (kind == K_NSA1) {
                nsa1_phase(C, ctl + 64 * (8 + L));
            } else if (kind == K_NSA2) {
                nsa2_phase(C, L, ctl + 64 * (16 + L));
            }
            grid.sync();
        }
    }
}

extern "C" void kernel_launch(void* const* d_in, const int* in_sizes, int n_in, void* d_out, int out_size, void* d_ws, size_t ws_size, hipStream_t stream) {
    static int grid = 0;
    if (grid == 0) {
        if (n_in != 19 || out_size != M * D || ws_size < WS_END) { fprintf(stderr, "kernel_launch: unexpected shapes (n_in %d, out %d, ws %zu)\n", n_in, out_size, ws_size); grid = -1; return; }
        int dev = 0, cus = 0, per_cu = 0;
        hipGetDevice(&dev); hipDeviceGetAttribute(&cus, hipDeviceAttributeMultiprocessorCount, dev);
        if (hipFuncSetAttribute((const void*)yoco_fwd, hipFuncAttributeMaxDynamicSharedMemorySize, LDS_BYTES) != hipSuccess) { fprintf(stderr, "kernel_launch: hipFuncSetAttribute failed\n"); grid = -1; return; }
        if (hipOccupancyMaxActiveBlocksPerMultiprocessor(&per_cu, (const void*)yoco_fwd, NTHR, LDS_BYTES) != hipSuccess || per_cu < 1) { fprintf(stderr, "kernel_launch: occupancy query gives %d\n", per_cu); per_cu = 1; }
        (void)hipGetLastError();
        grid = cus;
    }
    if (grid < 0) return;
    hipMemsetAsync((char*)d_ws + WS_CTL, 0, CTL_BYTES, stream);
    Args a{};
    for (int i = 0; i < 19; ++i) a.in[i] = (const float*)d_in[i];
    a.out = (float*)d_out; a.ws = (unsigned char*)d_ws;
    void* kargs[] = {&a};
    hipError_t e = hipLaunchCooperativeKernel((const void*)yoco_fwd, dim3(grid), dim3(NTHR), kargs, LDS_BYTES, stream);
    if (e != hipSuccess) fprintf(stderr, "cooperative launch failed: %s (grid %d)\n", hipGetErrorString(e), grid);
}
```

```cpp
#include <hip/hip_runtime.h>
#include <hip/hip_cooperative_groups.h>
#include <cstdio>
#include <cstdint>
namespace cg = cooperative_groups;
#ifndef REP_ATT
#define REP_ATT 1
#endif
#ifndef REP_N1
#define REP_N1 1
#endif
#ifndef REP_N2
#define REP_N2 1
#endif
#ifndef REP_SYNC
#define REP_SYNC 1
#endif
#ifndef USE_XBAR
#define USE_XBAR 1
#endif
#ifndef REP_LN
#define REP_LN 1
#endif
#ifndef ABL_SEL
#define ABL_SEL 1.f
#endif
#ifndef ABL_CMP
#define ABL_CMP 1.f
#endif
#ifndef ABL_WIN
#define ABL_WIN 1.f
#endif
#ifndef ABL_MEM
#define ABL_MEM 1.f
#endif
#ifndef ABL_MLA
#define ABL_MLA 1.f
#endif
namespace pg8 {
#define PG8_LAS __attribute__((address_space(3)))
typedef unsigned short bf16_t;
typedef short bf16x8 __attribute__((ext_vector_type(8)));
typedef float f32x4 __attribute__((ext_vector_type(4)));
typedef unsigned u32x4 __attribute__((ext_vector_type(4)));
constexpr int BM = 256, BK = 64, HALF = 128, HTB = HALF * BK * 2  , STAGE_BYTES = 8 * HTB, NXCD = 8, WGM = 8;

__host__ __device__ __forceinline__ int lds_byte(int r, int c) { const int st = (r >> 4) * 2 + (c >> 5), rr = r & 15, cc = c & 31, ob = rr * 64 + cc * 2; return st * 1024 + (ob ^ (((ob >> 9) & 1) << 5)); }
__host__ __device__ __forceinline__ void stage_rc(int b, int& R, int& C) { const int st = b / 1024, sb = b % 1024, swz = sb ^ (((sb >> 9) & 1) << 5); R = (st >> 1) * 16 + swz / 64; C = (st & 1) * 32 + (swz % 64) / 2; }
__host__ __device__ __forceinline__ int perm32(int rho) { const int n = rho >> 4, i = rho & 15; return 8 * (i >> 2) + 4 * n + (i & 3); }

struct Unit { int pm, pn; };
struct Gemm { const bf16_t* A; const bf16_t* Bt; int M, N, K, lda; };

struct StaticOrder {
    int nM, nN, nwg, G, c;
    __host__ __device__ void init(int M, int N, int G_, int c_) { nM = M / BM; nN = N / BM; nwg = nM * nN; G = G_; c = c_; }
    __host__ __device__ bool next(int i, Unit& u) const {
        const long L = (long)i * G + c; if (L >= nwg) return false;
        int wgid = (int)L; { const int q = nwg / NXCD, r = nwg % NXCD, xcd = wgid % NXCD, off = wgid / NXCD; wgid = (xcd < r ? xcd * (q + 1) : r * (q + 1) + (xcd - r) * q) + off; }
        const int nig = WGM * nN, gid = wgid / nig, fm = gid * WGM, gsz = (nM - fm) < WGM ? (nM - fm) : WGM;
        u.pm = fm + ((wgid % nig) % gsz); u.pn = (wgid % nig) / gsz; return true;
    }
    __device__ __forceinline__ void a_ready(const Unit&) const {}
    __device__ __forceinline__ void done(const Unit&) const {}
};

typedef _Float16 h16x2 __attribute__((ext_vector_type(2))); typedef _Float16 h16x8 __attribute__((ext_vector_type(8))); typedef float f32x2c __attribute__((ext_vector_type(2)));
__device__ __forceinline__ unsigned cvt_pk_bf16(float lo, float hi) { const f32x2c v = {lo, hi}; const h16x2 h = __builtin_convertvector(v, h16x2); return __builtin_bit_cast(unsigned, h); }
typedef float f32x2 __attribute__((ext_vector_type(2)));
typedef float f32x2 __attribute__((ext_vector_type(2)));
__device__ __forceinline__ float fexp2(float x) { return __builtin_amdgcn_exp2f(x); }
__device__ __forceinline__ float frcp(float x) { return __builtin_amdgcn_rcpf(x); }
__device__ __forceinline__ float sigmoidf_(float x) { return frcp(1.f + fexp2(-1.4426950408889634f * x)); }
__device__ __forceinline__ u32x4 pack8(f32x4 a, f32x4 b) { u32x4 w; w.x = cvt_pk_bf16(a[0], a[1]); w.y = cvt_pk_bf16(a[2], a[3]); w.z = cvt_pk_bf16(b[0], b[1]); w.w = cvt_pk_bf16(b[2], b[3]); return w; }
typedef unsigned u32x2 __attribute__((ext_vector_type(2)));
enum { EP_SWIGLU = 0, EP_RESID = 1, EP_F32 = 2, EP_UQ = 3, EP_UKV = 4, EP_NSAIN = 5, EP_KV = 6, EP_C1 = 7, EP_C2 = 8, EP_MEMKV = 9 };
struct Epi {
    static constexpr bool PERM = true, AFTER_DRAIN = false;
    int mode; bf16_t* o0; bf16_t* o1; float* of; const float* fin; float s0, s1;
    __device__ __forceinline__ void operator()(const f32x4 (&acc)[2][2][4][2], const Unit& u, int wr, int wc, int fr, int fq) const {
        const int rowb = u.pm * BM + wr * 64 + fr;
        const int lc = wc * 32 + 8 * fq;
        if (mode == EP_SWIGLU) {
#pragma unroll
            for (int ai = 0; ai < 2; ++ai)
#pragma unroll
                for (int m = 0; m < 4; ++m) { const size_t row = rowb + ai * HALF + m * 16;
                    f32x4 r[2];
#pragma unroll
                    for (int n = 0; n < 2; ++n) { const f32x4 g = acc[ai][0][m][n], uu = acc[ai][1][m][n];
#pragma unroll
                        for (int i = 0; i < 4; ++i) r[n][i] = g[i] * sigmoidf_(g[i]) * uu[i]; }
                    *(u32x4*)(o0 + row * 2816 + u.pn * 128 + lc) = pack8(r[0], r[1]); }
        } else if (mode == EP_RESID) {
#pragma unroll
            for (int ai = 0; ai < 2; ++ai)
#pragma unroll
                for (int m = 0; m < 4; ++m)
#pragma unroll
                    for (int bj = 0; bj < 2; ++bj) { const size_t off = (size_t)(rowb + ai * HALF + m * 16) * 1024 + u.pn * BM + bj * HALF + lc;
                        const f32x4 b0 = *(const f32x4*)(fin + off), b1 = *(const f32x4*)(fin + off + 4);
                        *(f32x4*)(of + off) = b0 * s0 + acc[ai][bj][m][0] * s1; *(f32x4*)(of + off + 4) = b1 * s0 + acc[ai][bj][m][1] * s1; }
        } else if (mode == EP_F32) {
#pragma unroll
            for (int ai = 0; ai < 2; ++ai)
#pragma unroll
                for (int m = 0; m < 4; ++m)
#pragma unroll
                    for (int bj = 0; bj < 2; ++bj) { const size_t off = (size_t)(rowb + ai * HALF + m * 16) * 768 + u.pn * BM + bj * HALF + lc;
                        *(f32x4*)(of + off) = acc[ai][bj][m][0]; *(f32x4*)(of + off + 4) = acc[ai][bj][m][1]; }
        } else if (mode == EP_UQ) {
            if (u.pn < 3) {
#pragma unroll
                for (int ai = 0; ai < 2; ++ai)
#pragma unroll
                    for (int m = 0; m < 4; ++m)
#pragma unroll
                        for (int bj = 0; bj < 2; ++bj) { const int c = u.pn * BM + bj * HALF + lc; const int h = c >> 6, d = c & 63;
                            *(u32x4*)(o0 + (size_t)(rowb + ai * HALF + m * 16) * 1152 + h * 96 + d) = pack8(acc[ai][bj][m][0] * s0, acc[ai][bj][m][1] * s0); }
            } else {
                const int h = (u.pn - 3) * 8 + (lc >> 4), j0 = lc & 15;
                if (h < 12) {
#pragma unroll
                    for (int ai = 0; ai < 2; ++ai)
#pragma unroll
                        for (int m = 0; m < 4; ++m) { const int row = rowb + ai * HALF + m * 16; const int pos = row & 8191;
                            const float* cs = fin + ((size_t)pos * 16 + j0) * 2;
                            f32x4 o1v[2], o2v[2];
#pragma unroll
                            for (int n = 0; n < 2; ++n) { const f32x4 x1 = acc[ai][0][m][n], x2 = acc[ai][1][m][n];
                                const f32x4 ca = *(const f32x4*)(cs + n * 8), cb = *(const f32x4*)(cs + n * 8 + 4);
                                const float co[4] = {ca[0], ca[2], cb[0], cb[2]}, si[4] = {ca[1], ca[3], cb[1], cb[3]};
#pragma unroll
                                for (int i = 0; i < 4; ++i) { o1v[n][i] = (x1[i] * co[i] - x2[i] * si[i]) * s0; o2v[n][i] = (x2[i] * co[i] + x1[i] * si[i]) * s0; } }
                            bf16_t* qp = o0 + (size_t)row * 1152 + h * 96 + 64 + j0;
                            *(u32x4*)(qp) = pack8(o1v[0], o1v[1]); *(u32x4*)(qp + 16) = pack8(o2v[0], o2v[1]); }
                }
            }
        } else if (mode == EP_UKV) {
#pragma unroll
            for (int ai = 0; ai < 2; ++ai)
#pragma unroll
                for (int m = 0; m < 4; ++m)
#pragma unroll
                    for (int bj = 0; bj < 2; ++bj) { const int h = u.pn * 2 + bj; bf16_t* dst = (lc < 64) ? (o0 + h * 64 + lc) : (o1 + h * 64 + lc - 64);
                        *(u32x4*)(dst + (size_t)(rowb + ai * HALF + m * 16) * 768) = pack8(acc[ai][bj][m][0], acc[ai][bj][m][1]); }
        } else if (mode == EP_NSAIN) {
#pragma unroll
            for (int ai = 0; ai < 2; ++ai)
#pragma unroll
                for (int m = 0; m < 4; ++m)
#pragma unroll
                    for (int bj = 0; bj < 2; ++bj) { const size_t row = rowb + ai * HALF + m * 16; const int c = bj * HALF + lc;
                        if (u.pn < 3) *(u32x4*)(o0 + row * 768 + u.pn * BM + c) = pack8(acc[ai][bj][m][0] * s0, acc[ai][bj][m][1] * s0);
                        else if (u.pn == 3) *(u32x4*)(o1 + row * 256 + c) = pack8(acc[ai][bj][m][0] * s0, acc[ai][bj][m][1] * s0);
                        else if (c < 40) {
#pragma unroll
                            for (int n = 0; n < 2; ++n)
#pragma unroll
                                for (int i = 0; i < 4; ++i) if (c + 4 * n + i < 36) of[row * 64 + c + 4 * n + i] = sigmoidf_(acc[ai][bj][m][n][i]); } }
        } else if (mode == EP_KV) {
#pragma unroll
            for (int ai = 0; ai < 2; ++ai)
#pragma unroll
                for (int m = 0; m < 4; ++m)
#pragma unroll
                    for (int bj = 0; bj < 2; ++bj) { const int row = rowb + ai * HALF + m * 16; const int c = u.pn * BM + bj * HALF + lc;
                        const int chunk = c >> 6, d = c & 63, b = row >> 13, t = row & 8191;
                        const size_t dst = ((((size_t)(chunk >> 1) * 2 + b) * 2 + (chunk & 1)) * 8192 + t) * 64 + d;
                        *(u32x4*)(o0 + dst) = pack8(acc[ai][bj][m][0], acc[ai][bj][m][1]); }
        } else if (mode == EP_C1) {
#pragma unroll
            for (int ai = 0; ai < 2; ++ai)
#pragma unroll
                for (int m = 0; m < 4; ++m)
#pragma unroll
                    for (int bj = 0; bj < 2; ++bj) { const size_t row = rowb + ai * HALF + m * 16; const int c = bj * HALF + lc;
                        f32x4 r[2];
#pragma unroll
                        for (int n = 0; n < 2; ++n) { const f32x4 bv = *(const f32x4*)(fin + c + 4 * n);
#pragma unroll
                            for (int i = 0; i < 4; ++i) { const float v = acc[ai][bj][m][n][i] + bv[i]; r[n][i] = v * sigmoidf_(1.5957691216057308f * (v + 0.044715f * v * v * v)); } }
                        *(u32x4*)(o0 + row * 256 + c) = pack8(r[0], r[1]); }
        } else if (mode == EP_C2) {
            if (lc < 64) {
#pragma unroll
                for (int ai = 0; ai < 2; ++ai)
#pragma unroll
                    for (int m = 0; m < 4; ++m) { const int row = rowb + ai * HALF + m * 16;
                        u32x4 w = pack8(acc[ai][0][m][0], acc[ai][0][m][1]); if ((row & 511) == 511) w = (u32x4){0u, 0u, 0u, 0u};
                        *(u32x4*)(o0 + (size_t)row * 64 + lc) = w; }
            }
        } else {
#pragma unroll
            for (int ai = 0; ai < 2; ++ai)
#pragma unroll
                for (int m = 0; m < 4; ++m)
#pragma unroll
                    for (int bj = 0; bj < 2; ++bj) { const int row = rowb + ai * HALF + m * 16; const int c = u.pn * BM + bj * HALF + lc;
                        const int layer = c >> 9, kvi = (c >> 8) & 1, h = (c >> 6) & 3, d = c & 63, b = row >> 8, mi = row & 255;
                        const size_t dst = (((((size_t)layer * 2 + kvi) * 2 + b) * 4 + h) * 256 + mi) * 64 + d;
                        *(u32x4*)(o0 + dst) = pack8(acc[ai][bj][m][0], acc[ai][bj][m][1]); }
        }
    }
};
template <class Epi, class Sched, bool ALIGN_EPI = false, bool SP2 = false>
__device__ __forceinline__ void gemm_phase(PG8_LAS unsigned char* lds, const Gemm g, const Sched& S, const Epi& E) {
    int tid_ = threadIdx.x; asm volatile("" : "+v"(tid_));
    const int tid = tid_, wid = __builtin_amdgcn_readfirstlane(tid >> 6), lane = tid & 63, wr = wid >> 2, wc = wid & 3, fr = lane & 15, fq = lane >> 4;
    const int K = g.K, nt = K / BK;
    unsigned voffA[2], voffB[2];
#pragma unroll
    for (int i = 0; i < 2; ++i) { int R, C; stage_rc(tid * 16 + i * 8192, R, C); const int Rb = Epi::PERM ? ((R & ~31) + perm32(R & 31)) : R;
        voffA[i] = (unsigned)(R * g.lda + C) * 2u; voffB[i] = (unsigned)(Rb * K + C) * 2u; }
    const size_t kstep = (size_t)(BK * 2);
    const size_t hstepA = (size_t)HALF * g.lda * 2, hstepB = (size_t)HALF * K * 2;
    const size_t tstepA = 2 * hstepA, tstepB = 2 * hstepB;
    const unsigned ldsw = (unsigned)wid * 1024u;
    const int aoff = lds_byte(wr * 64 + fr, fq * 8), boff = lds_byte(wc * 32 + fr, fq * 8);
#define PG8_SA(b, h) (((b) * 2 + (h)) * HTB)
#define PG8_SB(b, h) ((4 + (b) * 2 + (h)) * HTB)
#define PG8_STAGE(bufoff, gbase, voff) do { _Pragma("unroll") for (int _i = 0; _i < 2; ++_i) \
        __builtin_amdgcn_global_load_lds((const unsigned*)((const char*)(gbase) + (voff)[_i]), (PG8_LAS unsigned*)(lds + (bufoff) + ldsw + _i * 8192), 16, 0, 0); } while (0)
#define PG8_LDA(dst, b, h) do { _Pragma("unroll") for (int m = 0; m < 4; ++m) _Pragma("unroll") for (int k = 0; k < 2; ++k) dst[m][k] = *(const PG8_LAS bf16x8*)(lds + PG8_SA(b, h) + aoff + m * 2048 + k * 1024); } while (0)
#define PG8_LDB(dst, b, h) do { _Pragma("unroll") for (int n = 0; n < 2; ++n) _Pragma("unroll") for (int k = 0; k < 2; ++k) dst[n][k] = *(const PG8_LAS bf16x8*)(lds + PG8_SB(b, h) + boff + n * 2048 + k * 1024); } while (0)
#define PG8_MMA(ai, bj, At, Bt) do { __builtin_amdgcn_s_setprio(1); _Pragma("unroll") for (int m = 0; m < 4; ++m) _Pragma("unroll") for (int n = 0; n < 2; ++n) _Pragma("unroll") for (int k = 0; k < 2; ++k) \
        acc[ai][bj][m][n] = __builtin_amdgcn_mfma_f32_16x16x32_f16(__builtin_bit_cast(h16x8, Bt[n][k]), __builtin_bit_cast(h16x8, At[m][k]), acc[ai][bj][m][n], 0, 0, 0); __builtin_amdgcn_s_setprio(0); } while (0)
#define PG8_WAIT_V(n) asm volatile("s_waitcnt vmcnt(" #n ")" ::: "memory")
#define PG8_WAIT_L(n) asm volatile("s_waitcnt lgkmcnt(" #n ")" ::: "memory")
#define PG8_BAR __builtin_amdgcn_s_barrier()
#define PG8_SCHED __builtin_amdgcn_sched_barrier(0)
    Unit cur, nxt; int ui = 0;
    if (!S.next(0, cur)) return;
    f32x4 acc[2][2][4][2];
#pragma unroll
    for (int a = 0; a < 2; ++a)
#pragma unroll
        for (int b = 0; b < 2; ++b)
#pragma unroll
            for (int m = 0; m < 4; ++m)
#pragma unroll
                for (int n = 0; n < 2; ++n) acc[a][b][m][n] = (f32x4){0.f, 0.f, 0.f, 0.f};
    bf16x8 At[4][2], B0[2][2], B1[2][2];
    const char* cA = (const char*)g.A + (size_t)cur.pm * tstepA; const char* cB = (const char*)g.Bt + (size_t)cur.pn * tstepB;
    S.a_ready(cur);
    if constexpr (SP2) {
        PG8_STAGE(PG8_SB(0, 0), cB, voffB); PG8_STAGE(PG8_SB(0, 1), cB + hstepB, voffB); PG8_STAGE(PG8_SA(0, 0), cA, voffA); PG8_STAGE(PG8_SA(0, 1), cA + hstepA, voffA);
        if (wr == 1) PG8_BAR;
        PG8_WAIT_V(2); PG8_BAR;
        PG8_STAGE(PG8_SB(1, 0), cB + kstep, voffB); PG8_STAGE(PG8_SA(1, 0), cA + kstep, voffA); PG8_STAGE(PG8_SB(1, 1), cB + hstepB + kstep, voffB);
        PG8_WAIT_V(6); PG8_BAR;
    } else {
        PG8_STAGE(PG8_SB(0, 0), cB, voffB); PG8_STAGE(PG8_SA(0, 0), cA, voffA); PG8_STAGE(PG8_SB(0, 1), cB + hstepB, voffB); PG8_STAGE(PG8_SA(0, 1), cA + hstepA, voffA);
        if (wr == 1) PG8_BAR;
        PG8_WAIT_V(4); PG8_BAR;
        PG8_STAGE(PG8_SB(1, 0), cB + kstep, voffB); PG8_STAGE(PG8_SA(1, 0), cA + kstep, voffA); PG8_STAGE(PG8_SB(1, 1), cB + hstepB + kstep, voffB);
        PG8_WAIT_V(6); PG8_BAR;
    }
    for (;;) {
        const bool has_next = S.next(ui + 1, nxt);
        const char* nA = has_next ? (const char*)g.A + (size_t)nxt.pm * tstepA : cA; const char* nB = has_next ? (const char*)g.Bt + (size_t)nxt.pn * tstepB : cB;
        for (int t = 0; t < nt; t += 2) {
            const bool last = (t == nt - 2);
            const char* a1 = cA + (size_t)(t + 1) * kstep;
            const char* a2 = last ? nA : cA + (size_t)(t + 2) * kstep; const char* b2 = last ? nB : cB + (size_t)(t + 2) * kstep;
            const char* a3 = a2 + kstep; const char* b3 = b2 + kstep;
            if (last && has_next) S.a_ready(nxt);
            if constexpr (SP2) {
            PG8_LDB(B0, 0, 0); PG8_LDB(B1, 0, 1); PG8_SCHED; PG8_LDA(At, 0, 0); PG8_STAGE(PG8_SA(1, 1), a1 + hstepA, voffA);
            PG8_WAIT_V(8); PG8_WAIT_L(0); PG8_BAR; PG8_MMA(0, 0, At, B0); PG8_MMA(0, 1, At, B1); PG8_BAR; PG8_SCHED;
            PG8_LDA(At, 0, 1); PG8_STAGE(PG8_SB(0, 0), b2, voffB); PG8_STAGE(PG8_SB(0, 1), b2 + hstepB, voffB); PG8_STAGE(PG8_SA(0, 0), a2, voffA);
            PG8_WAIT_V(8); PG8_WAIT_L(0); PG8_BAR; PG8_MMA(1, 0, At, B0); PG8_MMA(1, 1, At, B1); PG8_BAR; PG8_SCHED;
            PG8_LDB(B0, 1, 0); PG8_LDB(B1, 1, 1); PG8_SCHED; PG8_LDA(At, 1, 0); PG8_STAGE(PG8_SA(0, 1), a2 + hstepA, voffA);
            PG8_WAIT_V(8); PG8_WAIT_L(0); PG8_BAR; PG8_MMA(0, 0, At, B0); PG8_MMA(0, 1, At, B1); PG8_BAR; PG8_SCHED;
            PG8_LDA(At, 1, 1); PG8_STAGE(PG8_SB(1, 0), b3, voffB); PG8_STAGE(PG8_SB(1, 1), b3 + hstepB, voffB); PG8_STAGE(PG8_SA(1, 0), a3, voffA);
            PG8_WAIT_V(8); PG8_WAIT_L(0); PG8_BAR; PG8_MMA(1, 0, At, B0); PG8_MMA(1, 1, At, B1); PG8_BAR; PG8_SCHED;
            } else {
            PG8_LDB(B0, 0, 0); PG8_SCHED; PG8_LDA(At, 0, 0); PG8_STAGE(PG8_SA(1, 1), a1 + hstepA, voffA);
            PG8_WAIT_L(8); PG8_BAR; PG8_WAIT_L(0); PG8_MMA(0, 0, At, B0); PG8_BAR; PG8_SCHED;
            PG8_LDB(B1, 0, 1); PG8_STAGE(PG8_SB(0, 0), b2, voffB);
            PG8_BAR; PG8_WAIT_L(0); PG8_MMA(0, 1, At, B1); PG8_BAR;
            PG8_LDA(At, 0, 1); PG8_STAGE(PG8_SA(0, 0), a2, voffA);
            PG8_BAR; PG8_WAIT_L(0); PG8_MMA(1, 0, At, B0); PG8_BAR; PG8_SCHED;
            PG8_STAGE(PG8_SB(0, 1), b2 + hstepB, voffB);
            PG8_WAIT_V(6); PG8_BAR; PG8_MMA(1, 1, At, B1); PG8_BAR;
            PG8_LDB(B0, 1, 0); PG8_SCHED; PG8_LDA(At, 1, 0); PG8_STAGE(PG8_SA(0, 1), a2 + hstepA, voffA);
            PG8_WAIT_L(8); PG8_BAR; PG8_WAIT_L(0); PG8_MMA(0, 0, At, B0); PG8_BAR; PG8_SCHED;
            PG8_LDB(B1, 1, 1); PG8_STAGE(PG8_SB(1, 0), b3, voffB);
            PG8_BAR; PG8_WAIT_L(0); PG8_MMA(0, 1, At, B1); PG8_BAR;
            PG8_LDA(At, 1, 1); PG8_STAGE(PG8_SA(1, 0), a3, voffA);
            PG8_BAR; PG8_WAIT_L(0); PG8_MMA(1, 0, At, B0); PG8_BAR; PG8_SCHED;
            PG8_STAGE(PG8_SB(1, 1), b3 + hstepB, voffB);
            PG8_WAIT_V(6); PG8_BAR; PG8_MMA(1, 1, At, B1); PG8_BAR;
            }
        }
        if constexpr (ALIGN_EPI) { if (wr == 0) PG8_BAR; }
        if constexpr (!Epi::AFTER_DRAIN) { E(acc, cur, wr, wc, fr, fq); S.done(cur); }
        if (!has_next) break;
#pragma unroll
        for (int a = 0; a < 2; ++a)
#pragma unroll
            for (int b = 0; b < 2; ++b)
#pragma unroll
                for (int m = 0; m < 4; ++m)
#pragma unroll
                    for (int n = 0; n < 2; ++n) acc[a][b][m][n] = (f32x4){0.f, 0.f, 0.f, 0.f};
        cur = nxt; cA = nA; cB = nB; ++ui;
        if constexpr (ALIGN_EPI) { if (wr == 1) PG8_BAR; }
    }
    PG8_WAIT_V(0);
    if constexpr (!ALIGN_EPI) { if (wr == 0) PG8_BAR; }
    PG8_BAR;
    if constexpr (Epi::AFTER_DRAIN) { E.fused(acc, cur, wr, wc, fr, fq, lds, wid, lane); S.done(cur); }
#undef PG8_SA
#undef PG8_SB
#undef PG8_STAGE
#undef PG8_LDA
#undef PG8_LDB
#undef PG8_MMA
#undef PG8_WAIT_V
#undef PG8_WAIT_L
#undef PG8_BAR
#undef PG8_SCHED
}
}
#define LAS __attribute__((address_space(3)))
typedef unsigned short bf16_t;
typedef short bf16x8 __attribute__((ext_vector_type(8)));
typedef float f32x4 __attribute__((ext_vector_type(4)));
typedef float f32x16 __attribute__((ext_vector_type(16)));
typedef unsigned u32x4 __attribute__((ext_vector_type(4)));
typedef unsigned u32x2 __attribute__((ext_vector_type(2)));
using pg8::cvt_pk_bf16; using pg8::fexp2; using pg8::frcp;
#define CR(r) (((r) & 3) + 8 * ((r) >> 2))
constexpr float LOG2E = 1.4426950408889634f;
constexpr int VS = 144;
constexpr int ABUF = 24576;
constexpr int AVOFF = 13312;
struct ASt { f32x16 o0, o1; float m, l; };
struct TReg { u32x4 k0, k1, v; };

template <bool ROPE> __device__ __forceinline__ void tile_load(TReg& R, const bf16_t* Kp, int pitchK, const bf16_t* KRp, const bf16_t* Vp, int pitchV, int tid) {
    const int key = tid >> 3, c = tid & 7;
    R.k0 = *(const u32x4*)(Kp + (size_t)key * pitchK + c * 8);
    R.v = *(const u32x4*)(Vp + (size_t)key * pitchV + c * 8);
    if (ROPE) { if (tid < 256) R.k1 = *(const u32x4*)(KRp + (size_t)(tid >> 2) * 32 + (tid & 3) * 8); }
}
template <int DQK> __device__ __forceinline__ void tile_store(const TReg& R, LAS unsigned char* buf, int tid) {
    constexpr int KS = DQK * 2 + 16;
    const int key = tid >> 3, c = tid & 7;
    *(LAS u32x4*)(buf + key * KS + c * 16) = R.k0;
    if (DQK == 96) { if (tid < 256) *(LAS u32x4*)(buf + (tid >> 2) * KS + 128 + (tid & 3) * 16) = R.k1; }
    const int k32 = key & 31, pos = (key & 32) + ((k32 >> 2) & 1) * 16 + ((k32 & 3) | ((k32 >> 3) << 2));
    LAS unsigned char* vt = buf + AVOFF + (c * 8) * VS + pos * 2;
    const unsigned w[4] = {R.v.x, R.v.y, R.v.z, R.v.w};
#pragma unroll
    for (int i = 0; i < 4; ++i) { *(LAS unsigned short*)(vt + (2 * i) * VS) = (unsigned short)(w[i] & 0xffffu); *(LAS unsigned short*)(vt + (2 * i + 1) * VS) = (unsigned short)(w[i] >> 16); }
}
template <int DQK> __device__ __forceinline__ void qk_tile(const LAS unsigned char* Kb, const bf16x8 (&qr)[DQK / 16], f32x16& s0, f32x16& s1, int r32, int hi) {
    constexpr int KS = DQK * 2 + 16;
    const LAS unsigned char* p = Kb + r32 * KS + hi * 16;
#pragma unroll
    for (int d0 = 0; d0 < DQK / 16; ++d0) {
        const bf16x8 a0 = *(const LAS bf16x8*)(p + d0 * 32), a1 = *(const LAS bf16x8*)(p + 32 * KS + d0 * 32);
        s0 = __builtin_amdgcn_mfma_f32_32x32x16_f16(__builtin_bit_cast(pg8::h16x8, a0), __builtin_bit_cast(pg8::h16x8, qr[d0]), s0, 0, 0, 0);
        s1 = __builtin_amdgcn_mfma_f32_32x32x16_f16(__builtin_bit_cast(pg8::h16x8, a1), __builtin_bit_cast(pg8::h16x8, qr[d0]), s1, 0, 0, 0);
    }
}
__device__ __forceinline__ void bias_init(f32x16& s0, f32x16& s1, float se, float sb) {
#pragma unroll
    for (int r = 0; r < 16; ++r) { s0[r] = se * (float)CR(r) + sb; s1[r] = se * (float)(CR(r) + 32) + sb; }
}
__device__ __forceinline__ void mask_tile(f32x16& s0, f32x16& s1, int lim, int lim2) {
#pragma unroll
    for (int r = 0; r < 16; ++r) {
        if (!(CR(r) <= lim && CR(r) > lim2)) s0[r] = -INFINITY;
        if (!(CR(r) + 32 <= lim && CR(r) + 32 > lim2)) s1[r] = -INFINITY;
    }
}
__device__ __forceinline__ bf16x8 pack_p(const f32x16& s, int b) {
    u32x4 w; w.x = cvt_pk_bf16(s[b], s[b + 1]); w.y = cvt_pk_bf16(s[b + 2], s[b + 3]); w.z = cvt_pk_bf16(s[b + 4], s[b + 5]); w.w = cvt_pk_bf16(s[b + 6], s[b + 7]);
    return __builtin_bit_cast(bf16x8, w);
}
__device__ __forceinline__ void pv_tile(f32x16& o0, f32x16& o1, const f32x16& s0, const f32x16& s1, const LAS unsigned char* VT, int r32, int hi) {
    const LAS unsigned char* vp = VT + r32 * VS + hi * 32;
    const bf16x8 p0 = pack_p(s0, 0), p1 = pack_p(s0, 8), p2 = pack_p(s1, 0), p3 = pack_p(s1, 8);
#define PV1(k4, P) { const bf16x8 v0 = *(const LAS bf16x8*)(vp + ((k4) >> 1) * 64 + ((k4) & 1) * 16), v1 = *(const LAS bf16x8*)(vp + 32 * VS + ((k4) >> 1) * 64 + ((k4) & 1) * 16); \
        o0 = __builtin_amdgcn_mfma_f32_32x32x16_f16(__builtin_bit_cast(pg8::h16x8, v0), __builtin_bit_cast(pg8::h16x8, P), o0, 0, 0, 0); o1 = __builtin_amdgcn_mfma_f32_32x32x16_f16(__builtin_bit_cast(pg8::h16x8, v1), __builtin_bit_cast(pg8::h16x8, P), o1, 0, 0, 0); }
    PV1(0, p0) PV1(1, p1) PV1(2, p2) PV1(3, p3)
#undef PV1
}
__device__ __forceinline__ float rowmax32(const f32x16& s0, const f32x16& s1) {
    float mx = fmaxf(s0[0], s1[0]);
#pragma unroll
    for (int r = 1; r < 16; ++r) mx = fmaxf(mx, fmaxf(s0[r], s1[r]));
    return fmaxf(mx, __shfl_xor(mx, 32));
}
__device__ __forceinline__ void softmax_pv(ASt& st, f32x16& s0, f32x16& s1, const LAS unsigned char* VT, int r32, int hi) {
    const float mnew = fmaxf(st.m, rowmax32(s0, s1));
    const float muse = (mnew == -INFINITY) ? 0.f : mnew;
    const float alpha = fexp2(st.m - muse);
    st.m = mnew;
    float ls = 0.f;
#pragma unroll
    for (int r = 0; r < 16; ++r) { s0[r] = fexp2(s0[r] - muse); s1[r] = fexp2(s1[r] - muse); ls += s0[r] + s1[r]; }
    st.l = st.l * alpha + ls;
#pragma unroll
    for (int r = 0; r < 16; ++r) { st.o0[r] *= alpha; st.o1[r] *= alpha; }
    pv_tile(st.o0, st.o1, s0, s1, VT, r32, hi);
}
__device__ __forceinline__ void softmax_stats(float& m, float& l, const f32x16& s0, const f32x16& s1) {
    const float mnew = fmaxf(m, rowmax32(s0, s1));
    const float muse = (mnew == -INFINITY) ? 0.f : mnew;
    const float alpha = fexp2(m - muse);
    m = mnew;
    float ls = 0.f;
#pragma unroll
    for (int r = 0; r < 16; ++r) ls += fexp2(s0[r] - muse) + fexp2(s1[r] - muse);
    l = l * alpha + ls;
}
__device__ __forceinline__ void ast_init(ASt& st) {
#pragma unroll
    for (int r = 0; r < 16; ++r) { st.o0[r] = 0.f; st.o1[r] = 0.f; }
    st.m = -INFINITY; st.l = 0.f;
}
__device__ __forceinline__ float ast_inv(const ASt& st) { const float lt = st.l + __shfl_xor(st.l, 32); return lt > 0.f ? 1.f / lt : 0.f; }
constexpr int NWAVES = 8, NTHR = 512;
constexpr int T = 8192, M = 16384, D = 1024, DFF = 2816;
constexpr size_t MiB = (size_t)1 << 20;
constexpr size_t WS_CTL = 0, CTL_BYTES = 65536, WS_ROPE = 1 * MiB, WS_CMPB = 2 * MiB;
constexpr size_t WS_WGU = 4 * MiB, WS_WDN = 92 * MiB, WS_WOUT = 136 * MiB, WS_WMLAIN = 144 * MiB, WS_WUQ = 147 * MiB, WS_WUKV = 149 * MiB, WS_WNSAIN = 150 * MiB,
                 WS_WKV = 155 * MiB, WS_WC1 = 157 * MiB, WS_WC2 = 159 * MiB, WS_WMEM = 160 * MiB, WS_MEMB = 164 * MiB, WS_MEMKV = 165 * MiB, WS_NSAKV = 167 * MiB,
                 WS_HID = 192 * MiB, WS_KCVC = 194 * MiB, WS_SEL = 195 * MiB, WS_GATES = 196 * MiB, WS_Z = 200 * MiB, WS_XB = 264 * MiB, WS_ACT = 296 * MiB,
                 WS_C768 = 296 * MiB, WS_Q = 344 * MiB, WS_K = 384 * MiB, WS_V = 408 * MiB, WS_KR = 432 * MiB, WS_CQN = 433 * MiB, WS_CKVN = 441 * MiB,
                 WS_QMEM = 445 * MiB, WS_MIX = 453 * MiB, WS_OACC = 485 * MiB, WS_END = 533 * MiB;
constexpr int LDS_BYTES = 147456, RING_BYTES = 131072, MISC_OFF = RING_BYTES, IMP_OFF = 49152, IMP_STRIDE = 132;
constexpr float DN_ALPHA = 1.681792830507429f;
__constant__ float ROPE_FREQ[16] = {1.000000000e+00f, 5.623413324e-01f, 3.162277639e-01f, 1.778279394e-01f, 1.000000015e-01f, 5.623413250e-02f, 3.162277490e-02f, 1.778279431e-02f,
                                    9.999999776e-03f, 5.623413250e-03f, 3.162277630e-03f, 1.778279431e-03f, 1.000000047e-03f, 5.623413017e-04f, 3.162277571e-04f, 1.778279402e-04f};
__constant__ float SLOPES[12] = {0.5f, 0.25f, 0.125f, 0.0625f, 0.03125f, 0.015625f, 0.0078125f, 0.00390625f, 0.7071067690849304f, 0.3535533845424652f, 0.1767766922712326f, 0.0883883461356163f};

struct Args { const float* in[19]; float* out; unsigned char* ws; };
struct Ctx {
    LAS unsigned char* lds; unsigned char* ws; const float* const* in; float* out;
    int tid, lane, wave, r32, hi, bid;
};
__device__ __forceinline__ float wave_sum(float v) {
#pragma unroll
    for (int o = 1; o < 64; o <<= 1) v += __shfl_xor(v, o);
    return v;
}
__device__ __forceinline__ unsigned f2bf(float f) { const _Float16 h = (_Float16)f; return (unsigned)__builtin_bit_cast(unsigned short, h); }
__device__ __forceinline__ unsigned pk2(float lo, float hi) { return f2bf(lo) | (f2bf(hi) << 16); }

enum { CM_ID = 0, CM_GU = 1, CM_MLAIN = 2, CM_UQ = 3, CM_NSAIN = 4, CM_C2 = 5 };
__device__ __forceinline__ int colmap(int id, int n) {
    switch (id) {
        case CM_GU: { const int pn = n >> 8, w = n & 255; return w < 128 ? pn * 128 + w : DFF + pn * 128 + (w - 128); }
        case CM_MLAIN: return n < 672 ? n : -1;
        case CM_UQ: { if (n < 768) return (n >> 6) * 96 + (n & 63); const int w = n - 768, tile = w >> 8, half = (w >> 7) & 1, lc = w & 127, h = tile * 8 + (lc >> 4), j = lc & 15; return h < 12 ? h * 96 + 64 + half * 16 + j : -1; }
        case CM_NSAIN: { if (n < 768) return n; if (n < 1024) return 804 + (n - 768); const int gi = n - 1024; return gi < 36 ? 768 + gi : -1; }
        case CM_C2: return n < 64 ? n : -1;
        default: return n;
    }
}
__device__ __forceinline__ void tr_item(const float* W, int K, int N, bf16_t* WT, int id, LAS float* scr, int item, int nblk, int lane) {
    const int kb = item / nblk, nb = item - kb * nblk, k0 = 64 * kb, n0 = 32 * nb;
    const int sc = colmap(id, n0 + (lane & 31));
#pragma unroll 8
    for (int i = 0; i < 32; ++i) { const int kk = 2 * i + (lane >> 5); scr[kk * 33 + (lane & 31)] = sc >= 0 ? W[(size_t)(k0 + kk) * N + sc] : 0.f; }
    asm volatile("s_waitcnt lgkmcnt(0)" ::: "memory");
    const int c = lane & 7;
#pragma unroll
    for (int j = 0; j < 4; ++j) { const int n = (lane >> 3) + 8 * j; const LAS float* s = scr + (8 * c) * 33 + n;
        u32x4 o; o.x = pk2(s[0 * 33], s[1 * 33]); o.y = pk2(s[2 * 33], s[3 * 33]); o.z = pk2(s[4 * 33], s[5 * 33]); o.w = pk2(s[6 * 33], s[7 * 33]);
        *(u32x4*)(WT + (size_t)(n0 + n) * K + k0 + 8 * c) = o; }
    asm volatile("s_waitcnt lgkmcnt(0)" ::: "memory");
}
__device__ __forceinline__ void prologue(const Ctx& C) {
    LAS float* scr = (LAS float*)(C.lds + C.wave * 16384);
    const int gw = C.bid * NWAVES + C.wave, NGW = gridDim.x * NWAVES;
    unsigned char* ws = C.ws;
#define FAM(SRC, SSTR, KK, NS, ND, DST, DSTR, MAPID, CNT) { const int ipm = ((KK) / 64) * ((ND) / 32); if (r < ipm * (CNT)) { const int mi = r / ipm; \
        tr_item((SRC) + (size_t)mi * (SSTR), (KK), (NS), (bf16_t*)(DST) + (size_t)mi * (DSTR), (MAPID), scr, r - mi * ipm, (ND) / 32, C.lane); continue; } r -= ipm * (CNT); }
    constexpr int NITEMS = 8 * 16 * 176 + 8 * 44 * 32 + 4 * 16 * 32 + 2 * 16 * 24 + 2 * 4 * 40 + 2 * 2 * 48 + 2 * 16 * 40 + 16 * 24 + 2 * 32 * 8 + 2 * 4 * 8 + 4 * 16 * 16;
    for (int it = gw; it < NITEMS; it += NGW) {
        int r = it;
        FAM(C.in[4], (size_t)D * 2 * DFF, D, 2 * DFF, 2 * DFF, ws + WS_WGU, (size_t)2 * DFF * D, CM_GU, 8)
        FAM(C.in[5], (size_t)DFF * D, DFF, D, D, ws + WS_WDN, (size_t)D * DFF, CM_ID, 8)
        FAM(C.in[7], (size_t)D * D, D, D, D, ws + WS_WOUT, (size_t)D * D, CM_ID, 4)
        FAM(C.in[8], (size_t)D * 672, D, 672, 768, ws + WS_WMLAIN, (size_t)768 * D, CM_MLAIN, 2)
        FAM(C.in[11], (size_t)256 * 1152, 256, 1152, 1280, ws + WS_WUQ, (size_t)1280 * 256, CM_UQ, 2)
        FAM(C.in[12], (size_t)128 * 1536, 128, 1536, 1536, ws + WS_WUKV, (size_t)1536 * 128, CM_ID, 2)
        FAM(C.in[13], (size_t)D * 1060, D, 1060, 1280, ws + WS_WNSAIN, (size_t)1280 * D, CM_NSAIN, 2)
        FAM(C.in[14], (size_t)0, D, 768, 768, ws + WS_WKV, (size_t)0, CM_ID, 1)
        FAM(C.in[16], (size_t)2048 * 256, 2048, 256, 256, ws + WS_WC1, (size_t)256 * 2048, CM_ID, 2)
        FAM(C.in[18], (size_t)256 * 64, 256, 64, 256, ws + WS_WC2, (size_t)256 * 256, CM_C2, 2)
        FAM(C.in[6], (size_t)D * 512, D, 512, 512, ws + WS_WMEM, (size_t)512 * D, CM_ID, 4)
    }
#undef FAM
    { float* rt = (float*)(ws + WS_ROPE);
      for (int i = C.bid * NTHR + C.tid; i < T * 16; i += gridDim.x * NTHR) {
          const float ang = (float)(i >> 4) * ROPE_FREQ[i & 15];
          const double a = (double)ang, k = __builtin_rint(a * 0.15915494309189535), rr = a - k * 6.283185307179586, r2 = rr * rr;
          double sn = -1.0 / 51090942171709440000.0;
          sn = sn * r2 + 1.0 / 121645100408832000.0; sn = sn * r2 - 1.0 / 355687428096000.0; sn = sn * r2 + 1.0 / 1307674368000.0; sn = sn * r2 - 1.0 / 6227020800.0; sn = sn * r2 + 1.0 / 39916800.0;
          sn = sn * r2 - 1.0 / 362880.0; sn = sn * r2 + 1.0 / 5040.0; sn = sn * r2 - 1.0 / 120.0; sn = sn * r2 + 1.0 / 6.0; sn = sn * r2 * -1.0 + 1.0; sn = sn * rr;
          double cs = 1.0 / 2432902008176640000.0;
          cs = cs * r2 - 1.0 / 6402373705728000.0; cs = cs * r2 + 1.0 / 20922789888000.0; cs = cs * r2 - 1.0 / 87178291200.0; cs = cs * r2 + 1.0 / 479001600.0; cs = cs * r2 - 1.0 / 3628800.0;
          cs = cs * r2 + 1.0 / 40320.0; cs = cs * r2 - 1.0 / 720.0; cs = cs * r2 + 1.0 / 24.0; cs = cs * r2 - 0.5; cs = cs * r2 + 1.0;
          rt[2 * i] = (float)cs; rt[2 * i + 1] = (float)sn; } }
    if (C.bid < 2) {
        const int j = C.bid; const float* w1 = C.in[16] + (size_t)j * 2048 * 256; const float* pos = C.in[15] + (size_t)j * 2048;
        f32x4 acc = {0.f, 0.f, 0.f, 0.f};
        for (int k = C.wave * 256; k < C.wave * 256 + 256; ++k) { const float p = pos[k]; const f32x4 w = *(const f32x4*)(w1 + (size_t)k * 256 + C.lane * 4); acc += w * p; }
        __syncthreads();
        *(LAS f32x4*)((LAS float*)(C.lds + C.wave * 16384 + 12288) + C.lane * 4) = acc;
        __syncthreads();
        if (C.tid < 256) { float s = C.in[17][j * 256 + C.tid];
#pragma unroll
            for (int w = 0; w < 8; ++w) s += ((LAS float*)(C.lds + w * 16384 + 12288))[C.tid];
            ((float*)(ws + WS_CMPB))[j * 256 + C.tid] = s; }
    }
    { const f32x4* x4 = (const f32x4*)C.in[0]; u32x2* xb = (u32x2*)(ws + WS_XB);
      for (size_t i = (size_t)C.bid * NTHR + C.tid; i < (size_t)M * D / 4; i += (size_t)gridDim.x * NTHR) { const f32x4 v = x4[i]; u32x2 o; o.x = pk2(v[0], v[1]); o.y = pk2(v[2], v[3]); xb[i] = o; }
      const f32x4* m4 = (const f32x4*)C.in[1]; u32x2* mb = (u32x2*)(ws + WS_MEMB);
      for (size_t i = (size_t)C.bid * NTHR + C.tid; i < (size_t)512 * D / 4; i += (size_t)gridDim.x * NTHR) { const f32x4 v = m4[i]; u32x2 o; o.x = pk2(v[0], v[1]); o.y = pk2(v[2], v[3]); mb[i] = o; } }
}
__device__ __forceinline__ void ln_phase(const Ctx& C, const float* Z, const float* g, const float* b, float* X, bf16_t* XB) {
    const int gw = C.bid * NWAVES + C.wave, NGW = gridDim.x * NWAVES;
    f32x4 gv[4], bv[4];
#pragma unroll
    for (int j = 0; j < 4; ++j) { gv[j] = *(const f32x4*)(g + C.lane * 4 + 256 * j); bv[j] = *(const f32x4*)(b + C.lane * 4 + 256 * j); }
    for (int row = gw; row < M; row += NGW) {
        const f32x4* zr = (const f32x4*)(Z + (size_t)row * D) + C.lane;
        f32x4 v[4]; float s = 0.f;
#pragma unroll
        for (int j = 0; j < 4; ++j) { v[j] = zr[64 * j]; s += (v[j][0] + v[j][1]) + (v[j][2] + v[j][3]); }
        const float mean = wave_sum(s) * (1.f / D); float s2 = 0.f;
#pragma unroll
        for (int j = 0; j < 4; ++j) { v[j] = v[j] - mean; s2 += (v[j][0] * v[j][0] + v[j][1] * v[j][1]) + (v[j][2] * v[j][2] + v[j][3] * v[j][3]); }
        const float rstd = 1.f / sqrtf(wave_sum(s2) * (1.f / D) + 1e-5f);
        f32x4* xo = (f32x4*)(X + (size_t)row * D) + C.lane; u32x2* bo = (u32x2*)(XB + (size_t)row * D) + C.lane;
#pragma unroll
        for (int j = 0; j < 4; ++j) { const f32x4 y = v[j] * rstd * gv[j] + bv[j]; xo[64 * j] = y; u32x2 o; o.x = pk2(y[0], y[1]); o.y = pk2(y[2], y[3]); bo[64 * j] = o; }
    }
}
__device__ __forceinline__ void prep_phase(const Ctx& C, const float* gq, const float* gkv) {
    const int gw = C.bid * NWAVES + C.wave, NGW = gridDim.x * NWAVES;
    unsigned char* ws = C.ws; const float* C768 = (const float*)(ws + WS_C768); const float* rope = (const float*)(ws + WS_ROPE);
    bf16_t* CQN = (bf16_t*)(ws + WS_CQN); bf16_t* CKVN = (bf16_t*)(ws + WS_CKVN); bf16_t* KR = (bf16_t*)(ws + WS_KR); bf16_t* QMEM = (bf16_t*)(ws + WS_QMEM);
    const f32x4 g1 = *(const f32x4*)(gq + C.lane * 4); const f32x4 g2 = *(const f32x4*)(gkv + (C.lane & 31) * 4);
    for (int row = gw; row < M; row += NGW) {
        const float* cr = C768 + (size_t)row * 768;
        const f32x4 cq = *(const f32x4*)(cr + C.lane * 4);
        f32x4 ckv = {0.f, 0.f, 0.f, 0.f}; if (C.lane < 32) ckv = *(const f32x4*)(cr + 256 + C.lane * 4);
        const f32x4 qm = *(const f32x4*)(cr + 416 + C.lane * 4);
        const float rq = 1.f / sqrtf(wave_sum((cq[0] * cq[0] + cq[1] * cq[1]) + (cq[2] * cq[2] + cq[3] * cq[3])) * (1.f / 256.f) + 1e-6f);
        const float rkv = 1.f / sqrtf(wave_sum((ckv[0] * ckv[0] + ckv[1] * ckv[1]) + (ckv[2] * ckv[2] + ckv[3] * ckv[3])) * (1.f / 128.f) + 1e-6f);
        { const f32x4 y = cq * rq * g1; u32x2 o; o.x = pk2(y[0], y[1]); o.y = pk2(y[2], y[3]); *((u32x2*)(CQN + (size_t)row * 256) + C.lane) = o; }
        if (C.lane < 32) { const f32x4 y = ckv * rkv * g2; u32x2 o; o.x = pk2(y[0], y[1]); o.y = pk2(y[2], y[3]); *((u32x2*)(CKVN + (size_t)row * 128) + C.lane) = o; }
        { const f32x4 y = qm * (0.125f * LOG2E); u32x2 o; o.x = pk2(y[0], y[1]); o.y = pk2(y[2], y[3]); *((u32x2*)(QMEM + (size_t)row * 256) + C.lane) = o; }
        if (C.lane < 16) { const float x1 = cr[384 + C.lane], x2 = cr[400 + C.lane]; const int pos = row & (T - 1); const float co = rope[(pos * 16 + C.lane) * 2], si = rope[(pos * 16 + C.lane) * 2 + 1];
            KR[(size_t)row * 32 + C.lane] = (bf16_t)f2bf(x1 * co - x2 * si); KR[(size_t)row * 32 + 16 + C.lane] = (bf16_t)f2bf(x2 * co + x1 * si); }
    }
}
#define STAGE_BUF(b) (C.lds + (b) * ABUF)
#define LDS_ADD(p, v) (void)__hip_atomic_fetch_add((p), (v), __ATOMIC_RELAXED, __HIP_MEMORY_SCOPE_WORKGROUP)
#define LDS_OR(p, v) (void)__hip_atomic_fetch_or((p), (v), __ATOMIC_RELAXED, __HIP_MEMORY_SCOPE_WORKGROUP)
__device__ __forceinline__ void store_o_bf16(const ASt& st, float inv, bf16_t* orow  , int hi) {
#pragma unroll
    for (int g4 = 0; g4 < 4; ++g4) {
        u32x2 w0, w1;
        w0.x = cvt_pk_bf16(st.o0[4 * g4] * inv, st.o0[4 * g4 + 1] * inv); w0.y = cvt_pk_bf16(st.o0[4 * g4 + 2] * inv, st.o0[4 * g4 + 3] * inv);
        w1.x = cvt_pk_bf16(st.o1[4 * g4] * inv, st.o1[4 * g4 + 1] * inv); w1.y = cvt_pk_bf16(st.o1[4 * g4 + 2] * inv, st.o1[4 * g4 + 3] * inv);
        *(u32x2*)(orow + 8 * g4 + 4 * hi) = w0; *(u32x2*)(orow + 32 + 8 * g4 + 4 * hi) = w1;
    }
}
template <bool MEM> __device__ __forceinline__ void mla_unit(const Ctx& C, int layer, int b, int h, int qb) {
    constexpr int DQK = MEM ? 64 : 96;
    unsigned char* ws = C.ws;
    const int t = qb * 256 + C.wave * 32 + C.r32; const size_t row = (size_t)b * T + t;
    bf16x8 qr[DQK / 16];
    const bf16_t *Kp, *Vp, *KRp = nullptr; int pitch;
    if (MEM) {
        const bf16_t* qp = (const bf16_t*)(ws + WS_QMEM) + row * 256 + h * 64 + C.hi * 8;
#pragma unroll
        for (int d0 = 0; d0 < DQK / 16; ++d0) qr[d0] = *(const bf16x8*)(qp + d0 * 16);
        const bf16_t* mk = (const bf16_t*)(ws + WS_MEMKV);
        Kp = mk + ((((size_t)layer * 2 + 0) * 2 + b) * 4 + h) * 256 * 64; Vp = mk + ((((size_t)layer * 2 + 1) * 2 + b) * 4 + h) * 256 * 64; pitch = 64;
    } else {
        const bf16_t* qp = (const bf16_t*)(ws + WS_Q) + row * 1152 + h * 96 + C.hi * 8;
#pragma unroll
        for (int d0 = 0; d0 < DQK / 16; ++d0) qr[d0] = *(const bf16x8*)(qp + d0 * 16);
        Kp = (const bf16_t*)(ws + WS_K) + (size_t)b * T * 768 + h * 64; Vp = (const bf16_t*)(ws + WS_V) + (size_t)b * T * 768 + h * 64; KRp = (const bf16_t*)(ws + WS_KR) + (size_t)b * T * 32; pitch = 768;
    }
    const int nt = MEM ? 4 : 4 * qb + 4, wlast = MEM ? 3 : 4 * qb + (C.wave >> 1), tmin = qb * 256 + C.wave * 32;
    ASt st; ast_init(st);
    TReg R;
    tile_load<!MEM>(R, Kp, pitch, KRp, Vp, pitch, C.tid);
    tile_store<DQK>(R, STAGE_BUF(0), C.tid);
    __syncthreads();
    for (int kt = 0; kt < nt; ++kt) {
        if (kt + 1 < nt) tile_load<!MEM>(R, Kp + (size_t)(kt + 1) * 64 * pitch, pitch, KRp + (size_t)(kt + 1) * 64 * 32, Vp + (size_t)(kt + 1) * 64 * pitch, pitch, C.tid);
        if (kt <= wlast) {
            const LAS unsigned char* buf = STAGE_BUF(kt & 1);
            f32x16 s0, s1;
#pragma unroll
            for (int r = 0; r < 16; ++r) { s0[r] = 0.f; s1[r] = 0.f; }
            qk_tile<DQK>(buf, qr, s0, s1, C.r32, C.hi);
            if (!MEM) { if (kt * 64 + 63 > tmin) mask_tile(s0, s1, t - kt * 64 - 4 * C.hi, -1000000); }
            softmax_pv(st, s0, s1, buf + AVOFF, C.r32, C.hi);
        }
        if (kt + 1 < nt) tile_store<DQK>(R, STAGE_BUF((kt + 1) & 1), C.tid);
        __syncthreads();
    }
    const float inv = ast_inv(st) * (MEM ? ABL_MEM : ABL_MLA);
    store_o_bf16(st, inv, (bf16_t*)(ws + WS_MIX) + row * 1024 + (MEM ? 768 : 0) + h * 64, C.hi);
}
__device__ __forceinline__ void mla_attn_phase(const Ctx& C, int layer, unsigned* ctr, bool with_mla) {
    LAS int* su = (LAS int*)(C.lds + MISC_OFF);
    const int nmla = with_mla ? 768 : 0, total = nmla + 256;
    for (;;) {
        __syncthreads();
        if (C.tid == 0) su[0] = (int)atomicAdd(ctr, 1u);
        __syncthreads();
        const int u = su[0];
        if (u >= total) break;
        if (u < nmla) { const int qb = 31 - u / 24, bh = u % 24; mla_unit<false>(C, layer, bh / 12, bh % 12, qb); }
        else { const int v = u - nmla; mla_unit<true>(C, layer, v >> 7, (v >> 5) & 3, v & 31); }
    }
}
__device__ __forceinline__ void nsa1_unit(const Ctx& C, int b, int g, int qb) {
    unsigned char* ws = C.ws;
    const int qsub = C.wave & 3, hh = C.wave >> 2;
    const int tmin = qb * 128 + qsub * 32, t = tmin + C.r32; const size_t row = (size_t)b * T + t;
    LAS unsigned* imp = (LAS unsigned*)(C.lds + IMP_OFF);
    for (int i = C.tid; i < 128 * IMP_STRIDE; i += NTHR) imp[i] = 0u;
    const int nt = ((8 * qb + 6) >> 6) + 1;
    const int nmax_w = 8 * qb + 2 * qsub, wlast = nmax_w >> 6;
    const int nfull = (tmin - 31) >> 4;
    const int nlim = (t - 31) >> 4;
    const bf16_t* Kp = (const bf16_t*)(ws + WS_KCVC) + (size_t)(b * 2 + g) * 512 * 64; const bf16_t* Vp = Kp + (size_t)4 * 512 * 64;
    const float* gates = (const float*)(ws + WS_GATES); float* OACC = (float*)(ws + WS_OACC);
    __syncthreads();
    for (int i3 = 0; i3 < 3; ++i3) {
        const int h = g * 6 + hh * 3 + i3;
        const float sl2 = SLOPES[h] * LOG2E, se = 16.f * sl2;
        bf16x8 qr[4];
        { const bf16_t* qp = (const bf16_t*)(ws + WS_Q) + row * 768 + h * 64 + C.hi * 8;
#pragma unroll
          for (int d0 = 0; d0 < 4; ++d0) qr[d0] = *(const bf16x8*)(qp + d0 * 16); }
        float m = -INFINITY, l = 0.f;
        TReg R;
        tile_load<false>(R, Kp, 64, nullptr, Vp, 64, C.tid); tile_store<64>(R, STAGE_BUF(0), C.tid); __syncthreads();
        for (int kt = 0; kt < nt; ++kt) {
            if (kt + 1 < nt) tile_load<false>(R, Kp + (size_t)(kt + 1) * 4096, 64, nullptr, Vp + (size_t)(kt + 1) * 4096, 64, C.tid);
            if (kt <= wlast) {
                const LAS unsigned char* buf = STAGE_BUF(kt & 1);
                f32x16 s0, s1; const int nb = kt * 64 + 4 * C.hi;
                bias_init(s0, s1, se, sl2 * ((float)(16 * nb - t) + 15.5f));
                qk_tile<64>(buf, qr, s0, s1, C.r32, C.hi);
                if (kt * 64 + 63 > nfull) mask_tile(s0, s1, nlim - nb, -1000000);
                softmax_stats(m, l, s0, s1);
            }
            if (kt + 1 < nt) tile_store<64>(R, STAGE_BUF((kt + 1) & 1), C.tid);
            __syncthreads();
        }
        const float lt = l + __shfl_xor(l, 32); const float inv = lt > 0.f ? 1.f / lt : 0.f; const float muse = (m == -INFINITY) ? 0.f : m;
        f32x16 o0, o1;
#pragma unroll
        for (int r = 0; r < 16; ++r) { o0[r] = 0.f; o1[r] = 0.f; }
        tile_load<false>(R, Kp, 64, nullptr, Vp, 64, C.tid); tile_store<64>(R, STAGE_BUF(0), C.tid); __syncthreads();
        for (int kt = 0; kt < nt; ++kt) {
            if (kt + 1 < nt) tile_load<false>(R, Kp + (size_t)(kt + 1) * 4096, 64, nullptr, Vp + (size_t)(kt + 1) * 4096, 64, C.tid);
            if (kt <= wlast) {
                const LAS unsigned char* buf = STAGE_BUF(kt & 1);
                f32x16 s0, s1; const int nb = kt * 64 + 4 * C.hi;
                bias_init(s0, s1, se, sl2 * ((float)(16 * nb - t) + 15.5f));
                qk_tile<64>(buf, qr, s0, s1, C.r32, C.hi);
                if (kt * 64 + 63 > nfull) mask_tile(s0, s1, nlim - nb, -1000000);
#pragma unroll
                for (int r = 0; r < 16; ++r) { s0[r] = fexp2(s0[r] - muse) * inv; s1[r] = fexp2(s1[r] - muse) * inv; }
                LAS unsigned* ip = imp + (qsub * 32 + C.r32) * IMP_STRIDE + kt * 16 + C.hi;
#pragma unroll
                for (int i4 = 0; i4 < 4; ++i4) {
                    { const float sp = 0.5f * s0[4 * i4 + 3], a = (s0[4 * i4] + s0[4 * i4 + 1]) + (s0[4 * i4 + 2] + sp);
                      LDS_ADD(ip + 2 * i4, (unsigned)(a * 134217728.f + 0.5f)); LDS_ADD(ip + 2 * i4 + 1, (unsigned)(sp * 134217728.f + 0.5f)); }
                    { const float sp = 0.5f * s1[4 * i4 + 3], a = (s1[4 * i4] + s1[4 * i4 + 1]) + (s1[4 * i4 + 2] + sp);
                      LDS_ADD(ip + 8 + 2 * i4, (unsigned)(a * 134217728.f + 0.5f)); LDS_ADD(ip + 8 + 2 * i4 + 1, (unsigned)(sp * 134217728.f + 0.5f)); }
                }
                pv_tile(o0, o1, s0, s1, buf + AVOFF, C.r32, C.hi);
            }
            if (kt + 1 < nt) tile_store<64>(R, STAGE_BUF((kt + 1) & 1), C.tid);
            __syncthreads();
        }
        const float gc = gates[row * 64 + h * 3 + 0] * ABL_CMP;
        float* op = OACC + row * 768 + h * 64 + 4 * C.hi;
#pragma unroll
        for (int g4 = 0; g4 < 4; ++g4) {
            *(f32x4*)(op + 8 * g4) = (f32x4){o0[4 * g4] * gc, o0[4 * g4 + 1] * gc, o0[4 * g4 + 2] * gc, o0[4 * g4 + 3] * gc};
            *(f32x4*)(op + 32 + 8 * g4) = (f32x4){o1[4 * g4] * gc, o1[4 * g4 + 1] * gc, o1[4 * g4 + 2] * gc, o1[4 * g4 + 3] * gc};
        }
    }
    __syncthreads();
    {
        const int ql = C.wave * 16 + (C.lane >> 2), sub = C.lane & 3, tq = qb * 128 + ql, cur = tq >> 6;
        const LAS unsigned* ip = imp + ql * IMP_STRIDE + sub * 32;
        unsigned k[32];
#pragma unroll
        for (int i = 0; i < 32; ++i) { const int j = sub * 32 + i; const unsigned v = ip[i]; const bool valid = j <= cur, forced = (j == 0) | (j == cur) | (j == cur - 1);
            k[i] = valid ? ((forced ? 0x80000000u : 0x40000000u) | (v < 0x3fffffffu ? v : 0x3fffffffu)) : 0u; }
        unsigned myword = 0u;
        for (int round = 0; round < 16; ++round) {
            unsigned best = 0u; int bi = 0;
#pragma unroll
            for (int i = 0; i < 32; ++i) if (k[i] > best) { best = k[i]; bi = i; }
            int gidx = sub * 32 + bi;
#pragma unroll
            for (int off = 1; off < 4; off <<= 1) { const unsigned ob = __shfl_xor(best, off); const int oi = __shfl_xor(gidx, off); if (ob > best || (ob == best && oi < gidx)) { best = ob; gidx = oi; } }
            if (best != 0u && (gidx >> 5) == sub) { const int bit = gidx & 31; myword |= 1u << bit;
#pragma unroll
                for (int i = 0; i < 32; ++i) if (i == bit) k[i] = 0u; }
        }
        ((unsigned*)(ws + WS_SEL))[((size_t)(b * 2 + g) * T + tq) * 4 + sub] = myword;
    }
}
__device__ __forceinline__ void nsa1_phase(const Ctx& C, unsigned* ctr) {
    LAS int* su = (LAS int*)(C.lds + MISC_OFF);
    for (;;) {
        __syncthreads();
        if (C.tid == 0) su[0] = (int)atomicAdd(ctr, 1u);
        __syncthreads();
        const int u = su[0];
        if (u >= 256) break;
        const int qb = 63 - (u >> 2), bg = u & 3;
        nsa1_unit(C, bg >> 1, bg & 1, qb);
    }
}
__device__ __forceinline__ int next_bit(unsigned u0, unsigned u1, unsigned u2, unsigned u3, int from) {
    if (from < 32) { const unsigned m = u0 & (~0u << from); if (m) return __builtin_ctz(m); from = 32; }
    if (from < 64) { const unsigned m = u1 & (~0u << (from - 32)); if (m) return 32 + __builtin_ctz(m); from = 64; }
    if (from < 96) { const unsigned m = u2 & (~0u << (from - 64)); if (m) return 64 + __builtin_ctz(m); from = 96; }
    if (from < 128) { const unsigned m = u3 & (~0u << (from - 96)); if (m) return 96 + __builtin_ctz(m); }
    return 128;
}
__device__ __forceinline__ void nsa2_unit(const Ctx& C, int b, int h, int qb) {
    unsigned char* ws = C.ws;
    const int g = h / 6;
    const int tmin = qb * 256 + C.wave * 32, tmax = tmin + 31, t = tmin + C.r32; const size_t row = (size_t)b * T + t;
    const float sl2 = SLOPES[h] * LOG2E;
    bf16x8 qr[4];
    { const bf16_t* qp = (const bf16_t*)(ws + WS_Q) + row * 768 + h * 64 + C.hi * 8;
#pragma unroll
      for (int d0 = 0; d0 < 4; ++d0) qr[d0] = *(const bf16x8*)(qp + d0 * 16); }
    const u32x4 selw = *(const u32x4*)((const unsigned*)(ws + WS_SEL) + ((size_t)(b * 2 + g) * T + t) * 4);
    const bf16_t* KV = (const bf16_t*)(ws + WS_NSAKV);
#define KVP(br, kvi) (KV + ((((size_t)(br) * 2 + (kvi)) * 2 + b) * 2 + g) * T * 64)
    const float* gates = (const float*)(ws + WS_GATES);
    f32x16 a0, a1;
    TReg R;
    {
        const bf16_t* Kp = KVP(2, 0); const bf16_t* Vp = KVP(2, 1);
        const int t0 = (4 * qb - 8) > 0 ? (4 * qb - 8) : 0, t1 = 4 * qb + 3;
        const int wlo = (tmin - 511) > 0 ? ((tmin - 511) >> 6) : 0, whi = tmax >> 6;
        ASt st; ast_init(st);
        tile_load<false>(R, Kp + (size_t)t0 * 4096, 64, nullptr, Vp + (size_t)t0 * 4096, 64, C.tid); tile_store<64>(R, STAGE_BUF(0), C.tid); __syncthreads();
        int pb = 0;
        for (int kt = t0; kt <= t1; ++kt) {
            if (kt < t1) tile_load<false>(R, Kp + (size_t)(kt + 1) * 4096, 64, nullptr, Vp + (size_t)(kt + 1) * 4096, 64, C.tid);
            if (kt >= wlo && kt <= whi) {
                const LAS unsigned char* buf = STAGE_BUF(pb);
                f32x16 s0, s1; const int kb = kt * 64 + 4 * C.hi;
                bias_init(s0, s1, sl2, sl2 * (float)(kb - t));
                qk_tile<64>(buf, qr, s0, s1, C.r32, C.hi);
                if (!(kt * 64 + 63 <= tmin && tmax - kt * 64 <= 511)) mask_tile(s0, s1, t - kb, t - kb - 512);
                softmax_pv(st, s0, s1, buf + AVOFF, C.r32, C.hi);
            }
            if (kt < t1) tile_store<64>(R, STAGE_BUF(pb ^ 1), C.tid);
            pb ^= 1;
            __syncthreads();
        }
        const float sc = ast_inv(st) * gates[row * 64 + h * 3 + 2] * ABL_WIN;
#pragma unroll
        for (int r = 0; r < 16; ++r) { a0[r] = st.o0[r] * sc; a1[r] = st.o1[r] * sc; }
    }
    ASt st; ast_init(st);
    {
        const bf16_t* Kp = KVP(1, 0); const bf16_t* Vp = KVP(1, 1);
        LAS unsigned* un = (LAS unsigned*)(C.lds + MISC_OFF + 64);
        if (C.tid < 4) un[C.tid] = 0u;
        __syncthreads();
        { unsigned w0 = selw.x, w1 = selw.y, w2 = selw.z, w3 = selw.w;
#pragma unroll
          for (int o = 1; o < 64; o <<= 1) { w0 |= __shfl_xor(w0, o); w1 |= __shfl_xor(w1, o); w2 |= __shfl_xor(w2, o); w3 |= __shfl_xor(w3, o); }
          if (C.lane == 0) { LDS_OR(un + 0, w0); LDS_OR(un + 1, w1); LDS_OR(un + 2, w2); LDS_OR(un + 3, w3); } }
        __syncthreads();
        const unsigned u0 = un[0], u1 = un[1], u2 = un[2], u3 = un[3];
        int j = next_bit(u0, u1, u2, u3, 0);
        int pb = 0;
        if (j < 128) { tile_load<false>(R, Kp + (size_t)j * 4096, 64, nullptr, Vp + (size_t)j * 4096, 64, C.tid); tile_store<64>(R, STAGE_BUF(0), C.tid); }
        __syncthreads();
        while (j < 128) {
            const int jn = next_bit(u0, u1, u2, u3, j + 1);
            if (jn < 128) tile_load<false>(R, Kp + (size_t)jn * 4096, 64, nullptr, Vp + (size_t)jn * 4096, 64, C.tid);
            const unsigned wsel = j < 32 ? selw.x : (j < 64 ? selw.y : (j < 96 ? selw.z : selw.w));
            const bool mine = (wsel >> (j & 31)) & 1u;
            if (__ballot(mine) != 0ull) {
                const LAS unsigned char* buf = STAGE_BUF(pb);
                f32x16 s0, s1; const int kb = j * 64 + 4 * C.hi;
                bias_init(s0, s1, sl2, sl2 * (float)(kb - t));
                qk_tile<64>(buf, qr, s0, s1, C.r32, C.hi);
                mask_tile(s0, s1, mine ? t - kb : -1000, -1000000);
                softmax_pv(st, s0, s1, buf + AVOFF, C.r32, C.hi);
            }
            if (jn < 128) tile_store<64>(R, STAGE_BUF(pb ^ 1), C.tid);
            pb ^= 1; j = jn;
            __syncthreads();
        }
    }
    {
        const float sc = ast_inv(st) * gates[row * 64 + h * 3 + 1] * ABL_SEL;
        const float* op = (const float*)(ws + WS_OACC) + row * 768 + h * 64 + 4 * C.hi;
        bf16_t* mp = (bf16_t*)(ws + WS_MIX) + row * 1024 + h * 64 + 4 * C.hi;
#pragma unroll
        for (int g4 = 0; g4 < 4; ++g4) {
            const f32x4 c0 = *(const f32x4*)(op + 8 * g4), c1 = *(const f32x4*)(op + 32 + 8 * g4);
            u32x2 w0, w1;
            w0.x = cvt_pk_bf16(c0[0] + a0[4 * g4] + st.o0[4 * g4] * sc, c0[1] + a0[4 * g4 + 1] + st.o0[4 * g4 + 1] * sc);
            w0.y = cvt_pk_bf16(c0[2] + a0[4 * g4 + 2] + st.o0[4 * g4 + 2] * sc, c0[3] + a0[4 * g4 + 3] + st.o0[4 * g4 + 3] * sc);
            w1.x = cvt_pk_bf16(c1[0] + a1[4 * g4] + st.o1[4 * g4] * sc, c1[1] + a1[4 * g4 + 1] + st.o1[4 * g4 + 1] * sc);
            w1.y = cvt_pk_bf16(c1[2] + a1[4 * g4 + 2] + st.o1[4 * g4 + 2] * sc, c1[3] + a1[4 * g4 + 3] + st.o1[4 * g4 + 3] * sc);
            *(u32x2*)(mp + 8 * g4) = w0; *(u32x2*)(mp + 32 + 8 * g4) = w1;
        }
    }
#undef KVP
}
__device__ __forceinline__ void nsa2_phase(const Ctx& C, int layer, unsigned* ctr) {
    LAS int* su = (LAS int*)(C.lds + MISC_OFF);
    const int total = 768 + 256;
    for (;;) {
        __syncthreads();
        if (C.tid == 0) su[0] = (int)atomicAdd(ctr, 1u);
        __syncthreads();
        const int u = su[0];
        if (u >= total) break;
        if (u < 768) { const int qb = 31 - u / 24, bh = u % 24; nsa2_unit(C, bh / 12, bh % 12, qb); }
        else { const int v = u - 768; mla_unit<true>(C, layer, v >> 7, (v >> 5) & 3, v & 31); }
    }
}
#define XB_TMO      128
#define XB_XCNT(j)  (256  + 64 * (j))
#define XB_XSUB(j)  (1280 + 64 * (j))
#define XB_XGEN(j)  (2304 + 64 * (j))
#define XB_TOP      3328
#define XB_TOPGEN   3392
#define XCD_BAR_WORDS 3456
#define XB_SPIN_CAP (1u << 18)

__device__ __forceinline__ unsigned xb_ld(unsigned* p)              { return __hip_atomic_load(p, __ATOMIC_RELAXED, __HIP_MEMORY_SCOPE_AGENT); }
__device__ __forceinline__ unsigned xb_add(unsigned* p, unsigned v) { return __hip_atomic_fetch_add(p, v, __ATOMIC_RELAXED, __HIP_MEMORY_SCOPE_AGENT); }
__device__ __forceinline__ unsigned xb_xcc_id() { return (unsigned)__builtin_amdgcn_s_getreg((3 << 11) | 20) & 0xFu; }
#define XB_SPIN(cond, bar) do { unsigned _sp = 0; while (cond) { __builtin_amdgcn_s_sleep(1); \
    if ((++_sp & 255u) == 0u) { if (xb_ld(&(bar)[XB_TMO])) break; if (_sp > XB_SPIN_CAP) { atomicAdd(&(bar)[XB_TMO], 1u); break; } } } } while (0)

struct XcdBarrier {
    unsigned* bar; unsigned x;
    volatile LAS unsigned* st;
};

__device__ __forceinline__ XcdBarrier xcd_barrier_post(unsigned* bar, volatile LAS unsigned* st) {
    XcdBarrier b; b.bar = bar; b.x = xb_xcc_id(); b.st = st;
    if (threadIdx.x == 0) (void)xb_add(&bar[XB_XCNT(b.x)], 1u);
    return b;
}
__device__ __forceinline__ void xcd_barrier_complete(unsigned* bar, unsigned x, unsigned& nloc, unsigned& nx) {
    const unsigned G = gridDim.x * gridDim.y * gridDim.z;
    unsigned sum, cnt, mine, sp = 0u;
    for (;;) {
        sum = 0u; cnt = 0u; mine = 0u;
#pragma unroll
        for (unsigned j = 0; j < 16; ++j) { const unsigned c = xb_ld(&bar[XB_XCNT(j)]); sum += c; cnt += (c > 0u) ? 1u : 0u; mine = (j == x) ? c : mine; }
        if (sum == G) break;
        __builtin_amdgcn_s_sleep(1);
        if ((++sp & 255u) == 0u) { if (xb_ld(&bar[XB_TMO])) break; if (sp > XB_SPIN_CAP) { atomicAdd(&bar[XB_TMO], 1u); break; } }
    }
    nloc = mine > 0u ? mine : 1u; nx = cnt > 0u ? cnt : 1u;
}

__device__ __forceinline__ void xcd_barrier(const XcdBarrier& b) {
    asm volatile("s_waitcnt vmcnt(0)" ::: "memory");
    __syncthreads();
    if (threadIdx.x == 0) {
        unsigned* bar = b.bar;
        __builtin_amdgcn_s_waitcnt(0);
        unsigned nloc = b.st[0], nx = b.st[1];
        if (nloc == 0u) { xcd_barrier_complete(bar, b.x, nloc, nx); b.st[0] = nloc; b.st[1] = nx; }
        const unsigned old = xb_add(&bar[XB_XSUB(b.x)], 1u);
        const unsigned gen = old / nloc;
        if (old + 1u == (gen + 1u) * nloc) {
            __builtin_amdgcn_fence(__ATOMIC_RELEASE, "agent");
            asm volatile("s_waitcnt vmcnt(0)" ::: "memory");
            const unsigned og = xb_add(&bar[XB_TOP], 1u);
            const unsigned tg = og / nx;
            if (og + 1u == (tg + 1u) * nx) xb_add(&bar[XB_TOPGEN], 1u);
            else XB_SPIN(xb_ld(&bar[XB_TOPGEN]) == tg, bar);
            __builtin_amdgcn_fence(__ATOMIC_ACQUIRE, "agent");
            xb_add(&bar[XB_XGEN(b.x)], 1u);
            asm volatile("s_waitcnt vmcnt(0)" ::: "memory");
        } else {
            XB_SPIN(xb_ld(&bar[XB_XGEN(b.x)]) == gen, bar);
            __builtin_amdgcn_fence(__ATOMIC_ACQUIRE, "agent");
            asm volatile("s_waitcnt vmcnt(0)" ::: "memory");
        }
    }
    __syncthreads();
}

struct GJob { const bf16_t* A; const bf16_t* Bt; int M, N, K, lda; pg8::Epi E; };
__device__ __forceinline__ GJob mkjob(const void* A, const void* Bt, int M_, int N_, int K_, int lda, int mode, void* o0, void* o1, float* of, const float* fin, float s0, float s1) {
    GJob j; j.A = (const bf16_t*)A; j.Bt = (const bf16_t*)Bt; j.M = M_; j.N = N_; j.K = K_; j.lda = lda;
    j.E.mode = mode; j.E.o0 = (bf16_t*)o0; j.E.o1 = (bf16_t*)o1; j.E.of = of; j.E.fin = fin; j.E.s0 = s0; j.E.s1 = s1; return j;
}
enum { K_NONE = 0, K_GEMM = 1, K_LN = 2, K_PREP = 3, K_ATT = 4, K_NSA1 = 5, K_NSA2 = 6 };

__global__ void __launch_bounds__(NTHR, 2) yoco_fwd(Args args) {
    extern __shared__ __attribute__((aligned(16))) unsigned char lds_raw[];
    cg::grid_group grid = cg::this_grid();
    float* X = args.out;
#define MAKE_CTX() unsigned char* ws = args.ws; asm volatile("" : "+s"(ws)); Ctx C; C.lds = (LAS unsigned char*)lds_raw; C.ws = ws; C.in = args.in; C.out = args.out; \
    { int t_ = threadIdx.x; asm volatile("" : "+v"(t_)); C.tid = t_; C.lane = t_ & 63; C.wave = __builtin_amdgcn_readfirstlane(t_ >> 6); C.r32 = t_ & 31; C.hi = (t_ >> 5) & 1; int b_ = blockIdx.x; asm volatile("" : "+s"(b_)); C.bid = b_; } \
    unsigned* ctl = (unsigned*)(ws + WS_CTL); float* Z = (float*)(ws + WS_Z); bf16_t* XB = (bf16_t*)(ws + WS_XB); (void)ctl; (void)Z; (void)XB;
    volatile LAS unsigned* bar_st = (volatile LAS unsigned*)((LAS unsigned char*)lds_raw + MISC_OFF + 128);
    if (threadIdx.x < 2) bar_st[threadIdx.x] = 0u;
    __syncthreads();
    const XcdBarrier xbar = xcd_barrier_post((unsigned*)(args.ws + WS_CTL) + 4096, bar_st);
#if USE_XBAR
#define GSYNC() xcd_barrier(xbar)
#else
#define GSYNC() grid.sync()
#endif
    { MAKE_CTX()
    prologue(C); }
    grid.sync();

    for (int L = 0; L < 4; ++L) {
        const bool mla = L < 2;
        const int nsteps = mla ? (L == 1 ? 15 : 12) : 11;
        for (int s = 0; s < nsteps; ++s) {
            MAKE_CTX()
            int kind = K_NONE, nj = 0, lnidx = 0;
            GJob j0, j1; j0 = mkjob(nullptr, nullptr, 0, 0, 0, 0, 0, nullptr, nullptr, nullptr, nullptr, 0.f, 0.f); j1 = j0;
            const int ffn_lo = mla ? 9 : 8;
            const bool inffn1 = s < 3, inffn2 = (s >= ffn_lo && s < ffn_lo + 3);
            if (inffn1 || inffn2) {
                const int f = inffn2 ? 1 : 0, fs = inffn2 ? s - ffn_lo : s;
                const float* xin = (L == 0 && f == 0) ? args.in[0] : X;
                if (fs == 0) { kind = K_GEMM; nj = 1; j0 = mkjob(XB, (bf16_t*)(ws + WS_WGU) + (size_t)(L * 2 + f) * 2 * DFF * D, M, 2 * DFF, D, D, pg8::EP_SWIGLU, ws + WS_ACT, nullptr, nullptr, nullptr, 0.f, 0.f);
                    if (L == 0 && f == 0) { nj = 2; j1 = mkjob(ws + WS_MEMB, ws + WS_WMEM, 512, 2048, D, D, pg8::EP_MEMKV, ws + WS_MEMKV, nullptr, nullptr, nullptr, 0.f, 0.f); } }
                else if (fs == 1) { kind = K_GEMM; nj = 1; j0 = mkjob(ws + WS_ACT, (bf16_t*)(ws + WS_WDN) + (size_t)(L * 2 + f) * D * DFF, M, D, DFF, DFF, pg8::EP_RESID, nullptr, nullptr, Z, xin, DN_ALPHA, 0.5f); }
                else { kind = K_LN; lnidx = f == 0 ? 0 : 2; }
            } else if (mla && s >= 12) {
                if (s == 12) { kind = K_GEMM; nj = 1; j0 = mkjob(XB, ws + WS_WKV, M, 768, D, D, pg8::EP_KV, ws + WS_NSAKV, nullptr, nullptr, nullptr, 0.f, 0.f); }
                else if (s == 13) { kind = K_GEMM; nj = 2;
                    j0 = mkjob(ws + WS_NSAKV, ws + WS_WC1, 2048, 256, 2048, 1024, pg8::EP_C1, ws + WS_HID, nullptr, nullptr, (const float*)(ws + WS_CMPB), 0.f, 0.f);
                    j1 = mkjob((bf16_t*)(ws + WS_NSAKV) + (size_t)4 * T * 64, (bf16_t*)(ws + WS_WC1) + (size_t)256 * 2048, 2048, 256, 2048, 1024, pg8::EP_C1, (bf16_t*)(ws + WS_HID) + (size_t)2048 * 256, nullptr, nullptr, (const float*)(ws + WS_CMPB) + 256, 0.f, 0.f); }
                else { kind = K_GEMM; nj = 2;
                    j0 = mkjob(ws + WS_HID, ws + WS_WC2, 2048, 256, 256, 256, pg8::EP_C2, ws + WS_KCVC, nullptr, nullptr, nullptr, 0.f, 0.f);
                    j1 = mkjob((bf16_t*)(ws + WS_HID) + (size_t)2048 * 256, (bf16_t*)(ws + WS_WC2) + (size_t)256 * 256, 2048, 256, 256, 256, pg8::EP_C2, (bf16_t*)(ws + WS_KCVC) + (size_t)4 * 512 * 64, nullptr, nullptr, nullptr, 0.f, 0.f); }
            } else if (mla) {
                const int ms = s - 3;
                if (ms == 0) { kind = K_GEMM; nj = 1; j0 = mkjob(XB, (bf16_t*)(ws + WS_WMLAIN) + (size_t)L * 768 * D, M, 768, D, D, pg8::EP_F32, nullptr, nullptr, (float*)(ws + WS_C768), nullptr, 0.f, 0.f); }
                else if (ms == 1) kind = K_PREP;
                else if (ms == 2) { kind = K_GEMM; nj = 2;
                    j0 = mkjob(ws + WS_CQN, (bf16_t*)(ws + WS_WUQ) + (size_t)L * 1280 * 256, M, 1280, 256, 256, pg8::EP_UQ, ws + WS_Q, nullptr, nullptr, (const float*)(ws + WS_ROPE), 0.10206207261596577f * LOG2E, 0.f);
                    j1 = mkjob(ws + WS_CKVN, (bf16_t*)(ws + WS_WUKV) + (size_t)L * 1536 * 128, M, 1536, 128, 128, pg8::EP_UKV, ws + WS_K, ws + WS_V, nullptr, nullptr, 0.f, 0.f); }
                else if (ms == 3) kind = K_ATT;
                else if (ms == 4) { kind = K_GEMM; nj = 1; j0 = mkjob(ws + WS_MIX, (bf16_t*)(ws + WS_WOUT) + (size_t)L * D * D, M, D, D, D, pg8::EP_RESID, nullptr, nullptr, Z, X, DN_ALPHA, 1.0f); }
                else { kind = K_LN; lnidx = 1; }
            } else {
                const int ms = s - 3;
                if (ms == 0) { kind = K_GEMM; nj = 1; j0 = mkjob(XB, (bf16_t*)(ws + WS_WNSAIN) + (size_t)(L - 2) * 1280 * D, M, 1280, D, D, pg8::EP_NSAIN, ws + WS_Q, ws + WS_QMEM, (float*)(ws + WS_GATES), nullptr, 0.125f * LOG2E, 0.f); }
                else if (ms == 1) kind = K_NSA1;
                else if (ms == 2) kind = K_NSA2;
                else if (ms == 3) { kind = K_GEMM; nj = 1; j0 = mkjob(ws + WS_MIX, (bf16_t*)(ws + WS_WOUT) + (size_t)L * D * D, M, D, D, D, pg8::EP_RESID, nullptr, nullptr, Z, X, DN_ALPHA, 1.0f); }
                else { kind = K_LN; lnidx = 1; }
            }
            if (kind == K_GEMM) {
                for (int q = 0; q < nj; ++q) {
                    const GJob& J = q ? j1 : j0;
                    pg8::Gemm g{J.A, J.Bt, J.M, J.N, J.K, J.lda}; pg8::StaticOrder S; S.init(J.M, J.N, (int)gridDim.x, C.bid);
                    pg8::gemm_phase<pg8::Epi, pg8::StaticOrder, true, true>((PG8_LAS unsigned char*)C.lds, g, S, J.E);
                }
            } else if (kind == K_LN) {
                for (int rep = 0; rep < REP_LN; ++rep) { ln_phase(C, Z, args.in[2] + (size_t)(L * 3 + lnidx) * D, args.in[3] + (size_t)(L * 3 + lnidx) * D, X, XB); if (rep + 1 < REP_LN) GSYNC(); }
            } else if (kind == K_PREP) {
                prep_phase(C, args.in[9] + (size_t)L * 256, args.in[10] + (size_t)L * 128);
            } else if (kind == K_ATT) {
                for (int rep = 0; rep < REP_ATT; ++rep) { mla_attn_phase(C, L, ctl + 64 * (1 + L) + 64 * 32 * rep, true); if (rep + 1 < REP_ATT) GSYNC(); }
            } else if (kind == K_NSA1) {
                for (int rep = 0; rep < REP_N1; ++rep) { nsa1_phase(C, ctl + 64 * (8 + L) + 64 * 32 * rep); if (rep + 1 < REP_N1) GSYNC(); }
            } else if (kind == K_NSA2) {
                for (int rep = 0; rep < REP_N2; ++rep) { nsa2_phase(C, L, ctl + 64 * (16 + L) + 64 * 32 * rep); if (rep + 1 < REP_N2) GSYNC(); }
            }
            GSYNC();
            for (int rep = 1; rep < REP_SYNC; ++rep) GSYNC();
        }
    }
}

extern "C" void kernel_launch(void* const* d_in, const int* in_sizes, int n_in, void* d_out, int out_size, void* d_ws, size_t ws_size, hipStream_t stream) {
    static int grid = 0;
    if (grid == 0) {
        if (n_in != 19 || out_size != M * D || ws_size < WS_END) { fprintf(stderr, "kernel_launch: unexpected shapes (n_in %d, out %d, ws %zu)\n", n_in, out_size, ws_size); grid = -1; return; }
        int dev = 0, cus = 0, per_cu = 0;
        hipGetDevice(&dev); hipDeviceGetAttribute(&cus, hipDeviceAttributeMultiprocessorCount, dev);
        if (hipFuncSetAttribute((const void*)yoco_fwd, hipFuncAttributeMaxDynamicSharedMemorySize, LDS_BYTES) != hipSuccess) { fprintf(stderr, "kernel_launch: hipFuncSetAttribute failed\n"); grid = -1; return; }
        if (hipOccupancyMaxActiveBlocksPerMultiprocessor(&per_cu, (const void*)yoco_fwd, NTHR, LDS_BYTES) != hipSuccess || per_cu < 1) { fprintf(stderr, "kernel_launch: occupancy query gives %d\n", per_cu); per_cu = 1; }
        (void)hipGetLastError();
        grid = cus;
    }
    if (grid < 0) return;
    hipMemsetAsync((char*)d_ws + WS_CTL, 0, CTL_BYTES, stream);
    Args a{};
    for (int i = 0; i < 19; ++i) a.in[i] = (const float*)d_in[i];
    a.out = (float*)d_out; a.ws = (unsigned char*)d_ws;
    void* kargs[] = {&a};
    hipError_t e = hipLaunchCooperativeKernel((const void*)yoco_fwd, dim3(grid), dim3(NTHR), kargs, LDS_BYTES, stream);
    if (e != hipSuccess) fprintf(stderr, "cooperative launch failed: %s (grid %d)\n", hipGetErrorString(e), grid);
}
```
